# Optimizing an MI355X kernel written in HIP

```python
import math
import jax, jax.numpy as jnp
from jax import lax
import numpy as np

D_MODEL = 1024
BATCH = 2
SEQ = 16384
DEPTH = 1

CHUNK = 64
Q_BLOCK = 128
DA_HEADS = 4
DA_QK_DIM = 64
DA_V_DIM = 2 * DA_QK_DIM
DA_WIDTH = DA_HEADS * DA_V_DIM
ML_HEADS = 4
ML_HEAD_DIM = 128
ML_WIDTH = ML_HEADS * ML_HEAD_DIM
CONV_K = 4
MIX_WIDTH = DA_WIDTH + ML_WIDTH
IN_GROUPS = (2 * DA_HEADS * DA_QK_DIM,
             2 * DA_HEADS * DA_QK_DIM,
             DA_WIDTH,
             ML_WIDTH,
             ML_WIDTH,
             ML_WIDTH,
             ML_WIDTH,
             ML_HEADS,
             ML_HEADS)
IN_COLS = 3 * 512 + 4 * 512 + 2 * ML_HEADS
D_FF = 2816
N_BUCKETS = 32
MAX_DISTANCE = 128
LN_EPS = 1e-5
ALPHA = (2.0 * DEPTH) ** 0.25
BETA = (8.0 * DEPTH) ** -0.25

kernel_name = "hybrid_diffattn_mlstm_macaron_deepnorm"


def layer_norm(x, g, b):
    xf = x.astype(jnp.float32)
    mu = jnp.mean(xf, -1, keepdims=True)
    var = jnp.mean(jnp.square(xf - mu), -1, keepdims=True)
    return ((xf - mu) * lax.rsqrt(var + LN_EPS)).astype(x.dtype) * g + b


def head_layer_norm(x, g):
    xf = x.astype(jnp.float32)
    mu = jnp.mean(xf, -1, keepdims=True)
    var = jnp.mean(jnp.square(xf - mu), -1, keepdims=True)
    return ((xf - mu) * lax.rsqrt(var + LN_EPS)).astype(x.dtype) * g


def rms_norm(x, g):
    xf = x.astype(jnp.float32)
    return (xf * lax.rsqrt(jnp.mean(jnp.square(xf), -1, keepdims=True) + LN_EPS)).astype(x.dtype) * g


def swiglu(x, w_up, w_down):
    a, u = jnp.split(x @ w_up, 2, axis=-1)
    return (jax.nn.silu(a) * u) @ w_down


def t5_bucket(rel):
    nb = N_BUCKETS // 2
    max_exact = nb // 2
    ret = jnp.where(rel > 0, nb, 0)
    n = jnp.abs(rel)
    nf = jnp.maximum(n, max_exact).astype(jnp.float32)
    large = max_exact + (jnp.log(nf / max_exact) / math.log(MAX_DISTANCE / max_exact)
                         * (nb - max_exact)).astype(jnp.int32)
    large = jnp.minimum(large, nb - 1)
    return ret + jnp.where(n < max_exact, n, large)


def diff_attention(q1, q2, k1, k2, v, lam, rel_bias):
    B, H, S, dq = q1.shape
    scale = dq ** -0.5
    k_pos = jnp.arange(S)

    def one_block(i):
        start = i * Q_BLOCK
        qb1 = lax.dynamic_slice_in_dim(q1, start, Q_BLOCK, axis=2)
        qb2 = lax.dynamic_slice_in_dim(q2, start, Q_BLOCK, axis=2)
        q_pos = start + jnp.arange(Q_BLOCK)
        bias = jnp.transpose(rel_bias[t5_bucket(k_pos[None, :] - q_pos[:, None])], (2, 0, 1))
        allowed = (k_pos[None, :] // CHUNK) <= (q_pos[:, None] // CHUNK)

        def probs(qb, k):
            s = jnp.einsum('bhqd,bhkd->bhqk', qb, k).astype(jnp.float32) * scale + bias
            return jax.nn.softmax(jnp.where(allowed, s, -jnp.inf), axis=-1)

        a = probs(qb1, k1) - lam * probs(qb2, k2)
        return jnp.einsum('bhqk,bhkd->bhqd', a.astype(v.dtype), v)

    out = lax.map(one_block, jnp.arange(S // Q_BLOCK))
    return jnp.transpose(out, (1, 2, 0, 3, 4)).reshape(B, H, S, v.shape[-1])


def mlstm_chunkwise(q, k, v, i_pre, f_pre):
    B, H, S, D = q.shape
    NC, L = S // CHUNK, CHUNK
    f32 = jnp.float32
    qc = q.astype(f32).reshape(B, H, NC, L, D)
    kc = (k.astype(f32) * D ** -0.5).reshape(B, H, NC, L, D)
    vc = v.astype(f32).reshape(B, H, NC, L, D)
    li = i_pre.astype(f32).reshape(B, H, NC, L)
    lf = jax.nn.log_sigmoid(f_pre.astype(f32)).reshape(B, H, NC, L)
    b = jnp.cumsum(lf, axis=-1)
    b_last = b[..., -1]
    g = b_last[..., None] - b + li
    m_loc = jnp.max(g, -1)
    w = jnp.exp(g - m_loc[..., None])
    kv_loc = jnp.einsum('bhcl,bhclv,bhclk->bhcvk', w, vc, kc)
    n_loc = jnp.einsum('bhcl,bhclk->bhck', w, kc)

    def step(carry, xs):
        C, n, m = carry
        bl, ml, kvl, nl = xs
        m_new = jnp.maximum(bl + m, ml)
        decay = jnp.exp(bl + m - m_new)
        sc = jnp.exp(ml - m_new)
        C_new = decay[..., None, None] * C + sc[..., None, None] * kvl
        n_new = decay[..., None] * n + sc[..., None] * nl
        return (C_new, n_new, m_new), (C, n, m)

    init = (jnp.zeros((B, H, D, D), f32), jnp.zeros((B, H, D), f32), jnp.zeros((B, H), f32))
    xs = (jnp.moveaxis(b_last, 2, 0), jnp.moveaxis(m_loc, 2, 0),
          jnp.moveaxis(kv_loc, 2, 0), jnp.moveaxis(n_loc, 2, 0))
    _, (C_prev, n_prev, m_prev) = lax.scan(step, init, xs)
    C_prev = jnp.moveaxis(C_prev, 0, 2)
    n_prev = jnp.moveaxis(n_prev, 0, 2)
    m_prev = jnp.moveaxis(m_prev, 0, 2)

    causal = jnp.tril(jnp.ones((L, L), dtype=bool))
    d_mat = jnp.where(causal, b[..., :, None] - b[..., None, :] + li[..., None, :], -jnp.inf)
    m_inter = b + m_prev[..., None]
    m_j = jnp.maximum(m_inter, jnp.max(d_mat, -1))
    s_mat = jnp.einsum('bhcjd,bhcsd->bhcjs', qc, kc) * jnp.exp(d_mat - m_j[..., None])
    inter_w = jnp.exp(m_inter - m_j)
    num = jnp.einsum('bhcjs,bhcsd->bhcjd', s_mat, vc) \
        + inter_w[..., None] * jnp.einsum('bhcvk,bhcjk->bhcjv', C_prev, qc)
    den = jnp.sum(s_mat, -1) + inter_w * jnp.einsum('bhck,bhcjk->bhcj', n_prev, qc)
    h = num / jnp.maximum(jnp.abs(den), jnp.exp(-m_j))[..., None]
    return h.reshape(B, H, S, D).astype(q.dtype)


def causal_conv(u, w, b):
    S = u.shape[1]
    up = jnp.pad(u, ((0, 0), (CONV_K - 1, 0), (0, 0)))
    return sum(up[:, j:j + S] * w[j] for j in range(CONV_K)) + b


def hybrid_mixer(h, w_in, conv_w, conv_b, gate_b_i, gate_b_f, lambda_q1, lambda_k1, lambda_q2, lambda_k2,
                 da_norm_g, ml_norm_g, w_out, rel_bias, layer_idx):
    B, S, _ = h.shape
    proj = h @ w_in
    offs, o = [], 0
    for c in IN_GROUPS[:-1]:
        o += c
        offs.append(o)
    da_q, da_k, da_v, ml_q, ml_k, ml_v, ml_o, ml_i, ml_f = jnp.split(proj, offs, axis=-1)

    lambda_init = 0.8 - 0.6 * math.exp(-0.3 * layer_idx)
    lam = (jnp.exp(jnp.sum(lambda_q1 * lambda_k1)) - jnp.exp(jnp.sum(lambda_q2 * lambda_k2))
           + lambda_init).astype(jnp.float32)
    qh = jnp.transpose(da_q.reshape(B, S, DA_HEADS, 2, DA_QK_DIM), (3, 0, 2, 1, 4))
    kh = jnp.transpose(da_k.reshape(B, S, DA_HEADS, 2, DA_QK_DIM), (3, 0, 2, 1, 4))
    vh = jnp.transpose(da_v.reshape(B, S, DA_HEADS, DA_V_DIM), (0, 2, 1, 3))
    da_out = diff_attention(qh[0], qh[1], kh[0], kh[1], vh, lam, rel_bias)
    da_out = rms_norm(da_out, da_norm_g) * (1.0 - lambda_init)
    da_out = jnp.transpose(da_out, (0, 2, 1, 3)).reshape(B, S, DA_WIDTH)

    qk = jax.nn.silu(causal_conv(jnp.concatenate([ml_q, ml_k], -1), conv_w, conv_b))
    mq, mk = jnp.split(qk, 2, axis=-1)
    to_heads = lambda t: jnp.transpose(t.reshape(B, S, ML_HEADS, ML_HEAD_DIM), (0, 2, 1, 3))
    i_pre = jnp.transpose(ml_i + gate_b_i, (0, 2, 1))
    f_pre = jnp.transpose(ml_f + gate_b_f, (0, 2, 1))
    ml_h = mlstm_chunkwise(to_heads(mq), to_heads(mk), to_heads(ml_v), i_pre, f_pre)
    ml_h = head_layer_norm(ml_h, ml_norm_g)
    ml_out = jnp.transpose(ml_h, (0, 2, 1, 3)).reshape(B, S, ML_WIDTH) * jax.nn.sigmoid(ml_o)

    return jnp.concatenate([da_out, ml_out], axis=-1) @ w_out


def setup_inputs(seed: int = 0) -> dict:
    key = jax.random.key(seed)
    ks = jax.random.split(key, 32)
    nrm = lambda k, shape, s: jax.random.normal(k, shape, jnp.float32) * s
    col_scale = np.ones((IN_COLS,), np.float32)
    v0 = IN_GROUPS[0] + IN_GROUPS[1]
    col_scale[v0:v0 + DA_WIDTH] = BETA
    mv0 = v0 + DA_WIDTH + 2 * ML_WIDTH
    col_scale[mv0:mv0 + ML_WIDTH] = BETA
    f_bias = jnp.linspace(3.0, 6.0, ML_HEADS, dtype=jnp.float32)
    return {
        "x": nrm(ks[0], (BATCH, SEQ, D_MODEL), 1.0),
        "ln1_g": 1.0 + nrm(ks[1], (DEPTH, D_MODEL), 0.02),
        "ln1_b": nrm(ks[2], (DEPTH, D_MODEL), 0.02),
        "ffn1_w_up": nrm(ks[3], (DEPTH, D_MODEL, 2 * D_FF), BETA * D_MODEL ** -0.5),
        "ffn1_w_down": nrm(ks[4], (DEPTH, D_FF, D_MODEL), BETA * D_FF ** -0.5),
        "w_in": nrm(ks[5], (DEPTH, D_MODEL, IN_COLS), D_MODEL ** -0.5) * jnp.asarray(col_scale),
        "conv_w": nrm(ks[6], (DEPTH, CONV_K, 2 * ML_WIDTH), CONV_K ** -0.5),
        "conv_b": nrm(ks[7], (DEPTH, 2 * ML_WIDTH), 0.02),
        "gate_b_i": nrm(ks[8], (DEPTH, ML_HEADS), 0.1),
        "gate_b_f": f_bias + nrm(ks[9], (DEPTH, ML_HEADS), 0.1),
        "lambda_q1": nrm(ks[10], (DEPTH, DA_QK_DIM), 0.1),
        "lambda_k1": nrm(ks[11], (DEPTH, DA_QK_DIM), 0.1),
        "lambda_q2": nrm(ks[12], (DEPTH, DA_QK_DIM), 0.1),
        "lambda_k2": nrm(ks[13], (DEPTH, DA_QK_DIM), 0.1),
        "da_norm_g": 1.0 + nrm(ks[14], (DEPTH, DA_V_DIM), 0.02),
        "ml_norm_g": 1.0 + nrm(ks[15], (DEPTH, ML_HEAD_DIM), 0.02),
        "w_out": nrm(ks[16], (DEPTH, MIX_WIDTH, D_MODEL), BETA * MIX_WIDTH ** -0.5),
        "ln2_g": 1.0 + nrm(ks[17], (DEPTH, D_MODEL), 0.02),
        "ln2_b": nrm(ks[18], (DEPTH, D_MODEL), 0.02),
        "ffn2_w_up": nrm(ks[19], (DEPTH, D_MODEL, 2 * D_FF), BETA * D_MODEL ** -0.5),
        "ffn2_w_down": nrm(ks[20], (DEPTH, D_FF, D_MODEL), BETA * D_FF ** -0.5),
        "ln3_g": 1.0 + nrm(ks[21], (DEPTH, D_MODEL), 0.02),
        "ln3_b": nrm(ks[22], (DEPTH, D_MODEL), 0.02),
        "rel_bias": nrm(ks[23], (N_BUCKETS, DA_HEADS), 0.2),
    }


def reference(x, ln1_g, ln1_b, ffn1_w_up, ffn1_w_down, w_in, conv_w, conv_b, gate_b_i, gate_b_f,
              lambda_q1, lambda_k1, lambda_q2, lambda_k2, da_norm_g, ml_norm_g, w_out,
              ln2_g, ln2_b, ffn2_w_up, ffn2_w_down, ln3_g, ln3_b, rel_bias):
    h = x
    for l in range(DEPTH):
        h = layer_norm(ALPHA * h + 0.5 * swiglu(h, ffn1_w_up[l], ffn1_w_down[l]), ln1_g[l], ln1_b[l])
        mix = hybrid_mixer(h, w_in[l], conv_w[l], conv_b[l], gate_b_i[l], gate_b_f[l],
                           lambda_q1[l], lambda_k1[l], lambda_q2[l], lambda_k2[l],
                           da_norm_g[l], ml_norm_g[l], w_out[l], rel_bias, l)
        h = layer_norm(ALPHA * h + mix, ln2_g[l], ln2_b[l])
        h = layer_norm(ALPHA * h + 0.5 * swiglu(h, ffn2_w_up[l], ffn2_w_down[l]), ln3_g[l], ln3_b[l])
    return h
```

```cpp
#include <hip/hip_runtime.h>
#include <hip/hip_cooperative_groups.h>
#include <cstdio>
#include <cstdint>
namespace cg = cooperative_groups;

#ifndef ONE_LAUNCH
#define ONE_LAUNCH 1
#endif

#define LAS __attribute__((address_space(3)))
typedef unsigned short bf16_t;
typedef short bf16x8 __attribute__((ext_vector_type(8)));
typedef short s16x4 __attribute__((ext_vector_type(4)));
typedef float f32x4 __attribute__((ext_vector_type(4)));
typedef float f32x2 __attribute__((ext_vector_type(2)));
typedef float f32x16 __attribute__((ext_vector_type(16)));
typedef unsigned u32x4 __attribute__((ext_vector_type(4)));
typedef unsigned u32x2 __attribute__((ext_vector_type(2)));
typedef __bf16 bf16x2_t __attribute__((ext_vector_type(2)));

constexpr int SEQ = 16384, BATCH = 2, M = BATCH * SEQ, D = 1024, FF = 2816, NUP = 2 * FF, NIN = 3584, INC = 3592;
constexpr float LN_EPS = 1e-5f;
constexpr float ALPHA = 1.189207115002721f;
constexpr float LOG2E = 1.4426950408889634f;
constexpr float QSCALE = 0.125f * LOG2E;
constexpr float KSCALE = 0.08838834764831845f;
constexpr float LAMBDA_INIT = 0.2f;

constexpr size_t MiB = 1u << 20;
constexpr size_t WS_WUP1 = 1 * MiB, WS_WD1 = 12 * MiB, WS_WIN = 18 * MiB, WS_WOUT = 25 * MiB, WS_WUP2 = 27 * MiB, WS_WD2 = 38 * MiB;
constexpr size_t WS_WG = 44 * MiB;
constexpr size_t WS_GATE = 45 * MiB;
constexpr size_t WS_NLOC = 46 * MiB;
constexpr size_t WS_SCAL = 47 * MiB;
constexpr size_t WS_XB = 48 * MiB;
constexpr size_t WS_BIG = 112 * MiB;
constexpr size_t WS_MQ = 336 * MiB, WS_MK = 368 * MiB;
constexpr size_t WS_KV = 400 * MiB;
constexpr size_t WS_VT = 464 * MiB;
constexpr size_t WS_END = 498 * MiB;
constexpr int VSTR = SEQ + 64;

constexpr int LDS_BYTES = 147456;

__device__ __forceinline__ float bf2f(bf16_t x) { return __uint_as_float(((unsigned)x) << 16); }
__device__ __forceinline__ unsigned cvtpk(float lo, float hi) { f32x2 v = {lo, hi}; bf16x2_t b = __builtin_convertvector(v, bf16x2_t); return __builtin_bit_cast(unsigned, b); }
__device__ __forceinline__ bf16_t f2bf(float f) { return (bf16_t)(cvtpk(f, 0.f) & 0xffffu); }
#define DPPF(v, ctrl) __builtin_bit_cast(float, __builtin_amdgcn_update_dpp(0, __builtin_bit_cast(int, (v)), (ctrl), 0xF, 0xF, true))
__device__ __forceinline__ float row16_sum(float v) {
    v += DPPF(v, 0xB1);  v += DPPF(v, 0x4E);  v += DPPF(v, 0x141);  v += DPPF(v, 0x140);
    return v;
}
__device__ __forceinline__ float half32_sum(float v) {
    v = row16_sum(v);
    auto rr = __builtin_amdgcn_permlane16_swap(__float_as_uint(v), __float_as_uint(v), false, false);
    return __uint_as_float(rr[0]) + __uint_as_float(rr[1]);
}
__device__ __forceinline__ float wave_sum(float v) {
    v = half32_sum(v);
    auto rr = __builtin_amdgcn_permlane32_swap(__float_as_uint(v), __float_as_uint(v), false, false);
    return __uint_as_float(rr[0]) + __uint_as_float(rr[1]);
}
__device__ __forceinline__ float wave_max(float v) {
    v = fmaxf(v, DPPF(v, 0xB1)); v = fmaxf(v, DPPF(v, 0x4E)); v = fmaxf(v, DPPF(v, 0x141)); v = fmaxf(v, DPPF(v, 0x140));
    { auto rr = __builtin_amdgcn_permlane16_swap(__float_as_uint(v), __float_as_uint(v), false, false); v = fmaxf(__uint_as_float(rr[0]), __uint_as_float(rr[1])); }
    { auto rr = __builtin_amdgcn_permlane32_swap(__float_as_uint(v), __float_as_uint(v), false, false); v = fmaxf(__uint_as_float(rr[0]), __uint_as_float(rr[1])); }
    return v;
}
__device__ __forceinline__ float fexp(float x) { return __builtin_amdgcn_exp2f(x * LOG2E); }
__device__ __forceinline__ float fsigmoid(float x) { return __builtin_amdgcn_rcpf(1.f + __builtin_amdgcn_exp2f(-x * LOG2E)); }
__device__ __forceinline__ int crow(int r, int hi) { return (r & 3) + 8 * (r >> 2) + 4 * hi; }
#define MFMA32(a, b, c) __builtin_amdgcn_mfma_f32_32x32x16_bf16((a), (b), (c), 0, 0, 0)

namespace pg8 {
constexpr int BM = 256, BK = 64, HALF = 128, HTB = HALF * BK * 2, STAGE_BYTES = 8 * HTB, NXCD = 8, WGM = 8;
__host__ __device__ __forceinline__ int lds_byte(int r, int c) { const int st = (r >> 4) * 2 + (c >> 5), rr = r & 15, cc = c & 31, ob = rr * 64 + cc * 2; return st * 1024 + (ob ^ (((ob >> 9) & 1) << 5)); }
__host__ __device__ __forceinline__ void stage_rc(int b, int& R, int& C) { const int st = b / 1024, sb = b % 1024, swz = sb ^ (((sb >> 9) & 1) << 5); R = (st >> 1) * 16 + swz / 64; C = (st & 1) * 32 + (swz % 64) / 2; }
__host__ __device__ __forceinline__ int perm32(int rho) { const int n = rho >> 4, i = rho & 15; return 8 * (i >> 2) + 4 * n + (i & 3); }
struct Unit { int pm, pn; };
struct Gemm { const bf16_t* A; const bf16_t* Bt; int M, N, K; };
struct StaticOrder {
    int nM, nN, nwg, G, c;
    __host__ __device__ void init(int M_, int N_, int G_, int c_) { nM = M_ / BM; nN = N_ / BM; nwg = nM * nN; G = G_; c = c_; }
    __host__ __device__ bool next(int i, Unit& u) const {
        const long L = (long)i * G + c; if (L >= nwg) return false;
        int wgid = (int)L; { const int q = nwg / NXCD, r = nwg % NXCD, xcd = wgid % NXCD, off = wgid / NXCD; wgid = (xcd < r ? xcd * (q + 1) : r * (q + 1) + (xcd - r) * q) + off; }
        const int nig = WGM * nN, gid = wgid / nig, fm = gid * WGM, gsz = (nM - fm) < WGM ? (nM - fm) : WGM;
        u.pm = fm + ((wgid % nig) % gsz); u.pn = (wgid % nig) / gsz; return true;
    }
};
struct EpiBf16 {
    static constexpr bool PERM = true;
    bf16_t* O; int ldc;
    __device__ __forceinline__ void operator()(const f32x4 (&acc)[2][2][4][2], const Unit& u, int wr, int wc, int fr, int fq) const {
        const int row0 = u.pm * BM + wr * 64 + fr; const int col0 = u.pn * BM + wc * 32 + 8 * fq;
#pragma unroll
        for (int ai = 0; ai < 2; ++ai)
#pragma unroll
            for (int m = 0; m < 4; ++m) { bf16_t* rowp = O + (size_t)(row0 + ai * HALF + m * 16) * ldc + col0;
#pragma unroll
                for (int bj = 0; bj < 2; ++bj) { const f32x4 v0 = acc[ai][bj][m][0], v1 = acc[ai][bj][m][1];
                    u32x4 w; w.x = cvtpk(v0[0], v0[1]); w.y = cvtpk(v0[2], v0[3]); w.z = cvtpk(v1[0], v1[1]); w.w = cvtpk(v1[2], v1[3]);
                    *(u32x4*)(rowp + bj * HALF) = w; } }
    }
};
__device__ __forceinline__ float silu_mul(float a, float u) { return a * u * __builtin_amdgcn_rcpf(1.0f + __builtin_amdgcn_exp2f(-a * LOG2E)); }
struct EpiSwiGLU {
    static constexpr bool PERM = true;
    bf16_t* O; int ldc;
    __device__ __forceinline__ void operator()(const f32x4 (&acc)[2][2][4][2], const Unit& u, int wr, int wc, int fr, int fq) const {
        const int row0 = u.pm * BM + wr * 64 + fr; const int col0 = u.pn * HALF + wc * 32 + 8 * fq;
#pragma unroll
        for (int ai = 0; ai < 2; ++ai)
#pragma unroll
            for (int m = 0; m < 4; ++m) { bf16_t* rowp = O + (size_t)(row0 + ai * HALF + m * 16) * ldc + col0;
                const f32x4 a0 = acc[ai][0][m][0], a1 = acc[ai][0][m][1], u0 = acc[ai][1][m][0], u1 = acc[ai][1][m][1];
                u32x4 w; w.x = cvtpk(silu_mul(a0[0], u0[0]), silu_mul(a0[1], u0[1])); w.y = cvtpk(silu_mul(a0[2], u0[2]), silu_mul(a0[3], u0[3]));
                w.z = cvtpk(silu_mul(a1[0], u1[0]), silu_mul(a1[1], u1[1])); w.w = cvtpk(silu_mul(a1[2], u1[2]), silu_mul(a1[3], u1[3]));
                *(u32x4*)rowp = w; }
    }
};
struct EpiResid {
    static constexpr bool PERM = false;
    const float* res; float* out; float alpha, s;
    __device__ __forceinline__ void operator()(const f32x4 (&acc)[2][2][4][2], const Unit& u, int wr, int wc, int fr, int fq) const {
        const int row0 = u.pm * BM + wr * 64 + fr; const int col0 = u.pn * BM + wc * 32 + 4 * fq;
#pragma unroll
        for (int ai = 0; ai < 2; ++ai)
#pragma unroll
            for (int m = 0; m < 4; ++m) { const size_t off = (size_t)(row0 + ai * HALF + m * 16) * D + col0;
#pragma unroll
                for (int bj = 0; bj < 2; ++bj)
#pragma unroll
                    for (int n = 0; n < 2; ++n) { const size_t o = off + bj * HALF + n * 16; const f32x4 rv = *(const f32x4*)(res + o); *(f32x4*)(out + o) = rv * alpha + acc[ai][bj][m][n] * s; } }
    }
};

template <class Epi>
__device__ __forceinline__ void gemm_phase(LAS unsigned char* lds, const Gemm g, const StaticOrder& S, const Epi& E) {
    const int tid = threadIdx.x, wid = __builtin_amdgcn_readfirstlane(tid >> 6), lane = tid & 63, wr = wid >> 2, wc = wid & 3, fr = lane & 15, fq = lane >> 4;
    const int K = g.K, nt = K / BK;
    unsigned voffA[2], voffB[2];
#pragma unroll
    for (int i = 0; i < 2; ++i) { int R, C; stage_rc(tid * 16 + i * 8192, R, C); const int Rb = Epi::PERM ? ((R & ~31) + perm32(R & 31)) : R;
        voffA[i] = (unsigned)(R * K + C) * 2u; voffB[i] = (unsigned)(Rb * K + C) * 2u; }
    const size_t kstep = (size_t)(BK * 2);
    const size_t hstep = (size_t)HALF * K * 2;
    const size_t tstep = 2 * hstep;
    const unsigned ldsw = (unsigned)wid * 1024u;
    const int aoff = lds_byte(wr * 64 + fr, fq * 8), boff = lds_byte(wc * 32 + fr, fq * 8);
#define PG8_SA(b, h) (((b) * 2 + (h)) * HTB)
#define PG8_SB(b, h) ((4 + (b) * 2 + (h)) * HTB)
#define PG8_STAGE(bufoff, gbase, voff) do { _Pragma("unroll") for (int _i = 0; _i < 2; ++_i) \
        __builtin_amdgcn_global_load_lds((const unsigned*)((const char*)(gbase) + (voff)[_i]), (LAS unsigned*)(lds + (bufoff) + ldsw + _i * 8192), 16, 0, 0); } while (0)
#define PG8_LDA(dst, b, h) do { _Pragma("unroll") for (int m = 0; m < 4; ++m) _Pragma("unroll") for (int k = 0; k < 2; ++k) dst[m][k] = *(const LAS bf16x8*)(lds + PG8_SA(b, h) + aoff + m * 2048 + k * 1024); } while (0)
#define PG8_LDB(dst, b, h) do { _Pragma("unroll") for (int n = 0; n < 2; ++n) _Pragma("unroll") for (int k = 0; k < 2; ++k) dst[n][k] = *(const LAS bf16x8*)(lds + PG8_SB(b, h) + boff + n * 2048 + k * 1024); } while (0)
#define PG8_MMA(ai, bj, At, Bt) do { __builtin_amdgcn_s_setprio(1); _Pragma("unroll") for (int m = 0; m < 4; ++m) _Pragma("unroll") for (int n = 0; n < 2; ++n) _Pragma("unroll") for (int k = 0; k < 2; ++k) \
        acc[ai][bj][m][n] = __builtin_amdgcn_mfma_f32_16x16x32_bf16(Bt[n][k], At[m][k], acc[ai][bj][m][n], 0, 0, 0); __builtin_amdgcn_s_setprio(0); } while (0)
#define PG8_WAIT_V(n) asm volatile("s_waitcnt vmcnt(" #n ")" ::: "memory")
#define PG8_WAIT_L(n) asm volatile("s_waitcnt lgkmcnt(" #n ")" ::: "memory")
#define PG8_BAR __builtin_amdgcn_s_barrier()
#define PG8_SCHED __builtin_amdgcn_sched_barrier(0)
    Unit cur, nxt; int ui = 0;
    if (!S.next(0, cur)) return;
    f32x4 acc[2][2][4][2];
#pragma unroll
    for (int a = 0; a < 2; ++a)
#pragma unroll
        for (int b = 0; b < 2; ++b)
#pragma unroll
            for (int m = 0; m < 4; ++m)
#pragma unroll
                for (int n = 0; n < 2; ++n) acc[a][b][m][n] = (f32x4){0.f, 0.f, 0.f, 0.f};
    bf16x8 At[4][2], B0[2][2], B1[2][2];
    const char* cA = (const char*)g.A + (size_t)cur.pm * tstep; const char* cB = (const char*)g.Bt + (size_t)cur.pn * tstep;
    PG8_STAGE(PG8_SB(0, 0), cB, voffB); PG8_STAGE(PG8_SB(0, 1), cB + hstep, voffB); PG8_STAGE(PG8_SA(0, 0), cA, voffA); PG8_STAGE(PG8_SA(0, 1), cA + hstep, voffA);
    if (wr == 1) PG8_BAR;
    PG8_WAIT_V(2); PG8_BAR;
    PG8_STAGE(PG8_SB(1, 0), cB + kstep, voffB); PG8_STAGE(PG8_SA(1, 0), cA + kstep, voffA); PG8_STAGE(PG8_SB(1, 1), cB + hstep + kstep, voffB);
    PG8_WAIT_V(6); PG8_BAR;
    for (;;) {
        const bool has_next = S.next(ui + 1, nxt);
        const char* nA = has_next ? (const char*)g.A + (size_t)nxt.pm * tstep : cA; const char* nB = has_next ? (const char*)g.Bt + (size_t)nxt.pn * tstep : cB;
        for (int t = 0; t < nt; t += 2) {
            const bool last = (t == nt - 2);
            const char* a1 = cA + (size_t)(t + 1) * kstep;
            const char* a2 = last ? nA : cA + (size_t)(t + 2) * kstep; const char* b2 = last ? nB : cB + (size_t)(t + 2) * kstep;
            const char* a3 = a2 + kstep; const char* b3 = b2 + kstep;
            PG8_LDB(B0, 0, 0); PG8_LDB(B1, 0, 1); PG8_SCHED; PG8_LDA(At, 0, 0); PG8_STAGE(PG8_SA(1, 1), a1 + hstep, voffA);
            PG8_WAIT_V(8); PG8_WAIT_L(0); PG8_BAR; PG8_MMA(0, 0, At, B0); PG8_MMA(0, 1, At, B1); PG8_BAR; PG8_SCHED;
            PG8_LDA(At, 0, 1); PG8_STAGE(PG8_SB(0, 0), b2, voffB); PG8_STAGE(PG8_SB(0, 1), b2 + hstep, voffB); PG8_STAGE(PG8_SA(0, 0), a2, voffA);
            PG8_WAIT_V(8); PG8_WAIT_L(0); PG8_BAR; PG8_MMA(1, 0, At, B0); PG8_MMA(1, 1, At, B1); PG8_BAR; PG8_SCHED;
            PG8_LDB(B0, 1, 0); PG8_LDB(B1, 1, 1); PG8_SCHED; PG8_LDA(At, 1, 0); PG8_STAGE(PG8_SA(0, 1), a2 + hstep, voffA);
            PG8_WAIT_V(8); PG8_WAIT_L(0); PG8_BAR; PG8_MMA(0, 0, At, B0); PG8_MMA(0, 1, At, B1); PG8_BAR; PG8_SCHED;
            PG8_LDA(At, 1, 1); PG8_STAGE(PG8_SB(1, 0), b3, voffB); PG8_STAGE(PG8_SB(1, 1), b3 + hstep, voffB); PG8_STAGE(PG8_SA(1, 0), a3, voffA);
            PG8_WAIT_V(8); PG8_WAIT_L(0); PG8_BAR; PG8_MMA(1, 0, At, B0); PG8_MMA(1, 1, At, B1); PG8_BAR; PG8_SCHED;
        }
        if (wr == 0) PG8_BAR;
        E(acc, cur, wr, wc, fr, fq);
        if (!has_next) break;
#pragma unroll
        for (int a = 0; a < 2; ++a)
#pragma unroll
            for (int b = 0; b < 2; ++b)
#pragma unroll
                for (int m = 0; m < 4; ++m)
#pragma unroll
                    for (int n = 0; n < 2; ++n) acc[a][b][m][n] = (f32x4){0.f, 0.f, 0.f, 0.f};
        cur = nxt; cA = nA; cB = nB; ++ui;
        if (wr == 1) PG8_BAR;
    }
    PG8_WAIT_V(0);
    PG8_BAR;
#undef PG8_SA
#undef PG8_SB
#undef PG8_STAGE
#undef PG8_LDA
#undef PG8_LDB
#undef PG8_MMA
#undef PG8_WAIT_V
#undef PG8_WAIT_L
#undef PG8_BAR
#undef PG8_SCHED
}
}

struct Args {
    const float* in[24];
    float* out;
    unsigned char* ws;
    int ph_lo, ph_hi;
};

#define SYNC() __syncthreads()

__device__ __forceinline__ void transpose_item(const float* W, int K, int ldw, int src_n0, bf16_t* WT, int dst_n0, int k0, float scale, LAS float* scr, int lane) {
#pragma unroll 8
    for (int i = 0; i < 32; ++i) { const int kk = 2 * i + (lane >> 5); scr[kk * 33 + (lane & 31)] = W[(size_t)(k0 + kk) * ldw + src_n0 + (lane & 31)]; }
    asm volatile("s_waitcnt lgkmcnt(0)" ::: "memory");
    const int c = lane & 7;
#pragma unroll
    for (int j = 0; j < 4; ++j) { const int n = (lane >> 3) + 8 * j; const LAS float* s = scr + (8 * c) * 33 + n;
        u32x4 o; o.x = cvtpk(s[0 * 33] * scale, s[1 * 33] * scale); o.y = cvtpk(s[2 * 33] * scale, s[3 * 33] * scale); o.z = cvtpk(s[4 * 33] * scale, s[5 * 33] * scale); o.w = cvtpk(s[6 * 33] * scale, s[7 * 33] * scale);
        *(u32x4*)(WT + (size_t)(dst_n0 + n) * K + k0 + 8 * c) = o; }
    asm volatile("s_waitcnt lgkmcnt(0)" ::: "memory");
}
__device__ __forceinline__ int up_src_col(int n0) { const int pn = n0 >> 8, j = n0 & 255; return (j < 128) ? pn * 128 + j : FF + pn * 128 + (j - 128); }

__device__ __forceinline__ void p0_prologue(const Args& a, LAS unsigned char* lds) {
    const int tid = threadIdx.x, lane = tid & 63, wid = tid >> 6;
    LAS float* scr = (LAS float*)(lds + wid * 16384);
    const int gw = blockIdx.x * 8 + wid, NGW = gridDim.x * 8;
    unsigned char* ws = a.ws;
    constexpr int I_UP = 16 * (NUP / 32), I_DN = (FF / 64) * (D / 32), I_IN = 16 * (NIN / 32), I_OUT = 16 * 32;
    constexpr int NITEMS = 2 * I_UP + 2 * I_DN + I_IN + I_OUT;
    for (int it = gw; it < NITEMS; it += NGW) {
        int r = it;
        if (r < 2 * I_UP) { const int which = r / I_UP; r -= which * I_UP; const int nblk = NUP / 32, kb = r / nblk, nb = r % nblk;
            transpose_item(a.in[which ? 19 : 3], D, NUP, up_src_col(32 * nb), (bf16_t*)(ws + (which ? WS_WUP2 : WS_WUP1)), 32 * nb, 64 * kb, 1.f, scr, lane); continue; }
        r -= 2 * I_UP;
        if (r < 2 * I_DN) { const int which = r / I_DN; r -= which * I_DN; const int nblk = D / 32, kb = r / nblk, nb = r % nblk;
            transpose_item(a.in[which ? 20 : 4], FF, D, 32 * nb, (bf16_t*)(ws + (which ? WS_WD2 : WS_WD1)), 32 * nb, 64 * kb, 1.f, scr, lane); continue; }
        r -= 2 * I_DN;
        if (r < I_IN) { const int nblk = NIN / 32, kb = r / nblk, nb = r % nblk;
            transpose_item(a.in[5], D, INC, 32 * nb, (bf16_t*)(ws + WS_WIN), 32 * nb, 64 * kb, (32 * nb < 512) ? QSCALE : 1.f, scr, lane); continue; }
        r -= I_IN;
        { const int nblk = D / 32, kb = r / nblk, nb = r % nblk;
            transpose_item(a.in[16], D, D, 32 * nb, (bf16_t*)(ws + WS_WOUT), 32 * nb, 64 * kb, 1.f, scr, lane); }
    }
    { float* wg = (float*)(ws + WS_WG); const float* win = a.in[5];
      for (int i = blockIdx.x * 512 + tid; i < 8 * D; i += gridDim.x * 512) { const int j = i >> 10, k = i & 1023; wg[i] = win[(size_t)k * INC + NIN + j]; } }
    { const f32x4* x4 = (const f32x4*)a.in[0]; u32x4* xb = (u32x4*)(ws + WS_XB);
      const size_t n8 = (size_t)M * D / 8;
      const size_t stride = (size_t)gridDim.x * 512;
      for (size_t i = (size_t)blockIdx.x * 512 + tid; i < n8; i += 4 * stride) { f32x4 v[4][2];
#pragma unroll
          for (int k = 0; k < 4; ++k) { const size_t ii = i + k * stride; if (ii < n8) { v[k][0] = x4[2 * ii]; v[k][1] = x4[2 * ii + 1]; } }
#pragma unroll
          for (int k = 0; k < 4; ++k) { const size_t ii = i + k * stride; if (ii < n8) { u32x4 o; o.x = cvtpk(v[k][0][0], v[k][0][1]); o.y = cvtpk(v[k][0][2], v[k][0][3]); o.z = cvtpk(v[k][1][0], v[k][1][1]); o.w = cvtpk(v[k][1][2], v[k][1][3]); xb[ii] = o; } } } }
}

template <bool WRITE_BF16, bool GATES>
__device__ __forceinline__ void ln_phase(const Args& a, LAS unsigned char* lds, float* hbuf, const float* g, const float* b) {
    const int tid = threadIdx.x, lane = tid & 63, wid = tid >> 6;
    LAS float* wgs = (LAS float*)lds;
    if (GATES) { const float* wg = (const float*)(a.ws + WS_WG); for (int i = tid; i < 8 * D; i += 512) wgs[i] = wg[i]; SYNC(); }
    f32x4 gv[4], bv[4];
#pragma unroll
    for (int j = 0; j < 4; ++j) { gv[j] = *(const f32x4*)(g + 4 * lane + 256 * j); bv[j] = *(const f32x4*)(b + 4 * lane + 256 * j); }
    bf16_t* xb = (bf16_t*)(a.ws + WS_XB); float* gate = (float*)(a.ws + WS_GATE);
    const int gw = blockIdx.x * 8 + wid, NGW = gridDim.x * 8;
    for (int m0 = 2 * gw; m0 < M; m0 += 2 * NGW) {
        f32x4 vv[2][4];
#pragma unroll
        for (int rr = 0; rr < 2; ++rr) { const f32x4* xr = (const f32x4*)(hbuf + (size_t)(m0 + rr) * D) + lane;
#pragma unroll
            for (int j = 0; j < 4; ++j) vv[rr][j] = xr[64 * j]; }
#pragma unroll
        for (int rr = 0; rr < 2; ++rr) {
            const int m = m0 + rr;
            f32x4* xr = (f32x4*)(hbuf + (size_t)m * D) + lane;
            f32x4 v[4]; float s = 0.f;
#pragma unroll
            for (int j = 0; j < 4; ++j) { v[j] = vv[rr][j]; s += (v[j][0] + v[j][1]) + (v[j][2] + v[j][3]); }
            const float mean = wave_sum(s) * (1.f / D); float s2 = 0.f;
#pragma unroll
            for (int j = 0; j < 4; ++j) { v[j] = v[j] - mean; s2 += (v[j][0] * v[j][0] + v[j][1] * v[j][1]) + (v[j][2] * v[j][2] + v[j][3] * v[j][3]); }
            const float rstd = 1.f / sqrtf(wave_sum(s2) * (1.f / D) + LN_EPS);
#pragma unroll
            for (int j = 0; j < 4; ++j) { v[j] = v[j] * rstd * gv[j] + bv[j]; xr[64 * j] = v[j]; }
            if (WRITE_BF16) { u32x2* o8 = (u32x2*)(xb + (size_t)m * D) + lane;
#pragma unroll
                for (int j = 0; j < 4; ++j) { u32x2 o; o.x = cvtpk(v[j][0], v[j][1]); o.y = cvtpk(v[j][2], v[j][3]); o8[64 * j] = o; } }
            if (GATES) {
                float p[8];
#pragma unroll
                for (int q = 0; q < 8; ++q) { float acc = 0.f;
#pragma unroll
                    for (int j = 0; j < 4; ++j) { const f32x4 w = *(const LAS f32x4*)(wgs + q * D + 4 * lane + 256 * j); acc += (v[j][0] * w[0] + v[j][1] * w[1]) + (v[j][2] * w[2] + v[j][3] * w[3]); }
                    p[q] = wave_sum(acc); }
                if (lane < 8) { float val = p[0];
#pragma unroll
                    for (int q = 1; q < 8; ++q) val = (lane == q) ? p[q] : val;
                    const float bias = (lane < 4) ? a.in[8][lane] : a.in[9][lane - 4];
                    gate[(size_t)m * 8 + lane] = val + bias; }
            }
        }
    }
    if (GATES) SYNC();
}

__device__ __forceinline__ void ml_pre_unit(const Args& a, LAS unsigned char* lds, int unit) {
    const int tid = threadIdx.x, lane = tid & 63, wid = tid >> 6, l32 = lane & 31, hi = lane >> 5;
    const int bh = unit >> 8, c = unit & 255, b = bh >> 2, h = bh & 3;
    const size_t row0 = (size_t)b * SEQ + c * 64;
    LAS bf16_t* Kt = (LAS bf16_t*)lds;
    LAS bf16_t* Vw = (LAS bf16_t*)(lds + 18432);
    LAS float* wl = (LAS float*)(lds + 36864);
    unsigned char* ws = a.ws;
    const bf16_t* proj = (const bf16_t*)(ws + WS_BIG);
    float* scal = (float*)(ws + WS_SCAL);
    if (wid == 0) {
        const float* gp = (const float*)(ws + WS_GATE) + (row0 + lane) * 8;
        const float ii = gp[h], fi = gp[4 + h];
        const float lf = fminf(fi, 0.f) - log1pf(expf(-fabsf(fi)));
        float bc = lf;
#pragma unroll
        for (int o = 1; o < 64; o <<= 1) { const float t = __shfl_up(bc, o); if (lane >= o) bc += t; }
        const float blast = __shfl(bc, 63);
        const float gg = blast - bc + ii;
        const float mloc = wave_max(gg);
        wl[lane] = expf(gg - mloc);
        scal[6144 + (size_t)bh * SEQ + c * 64 + lane] = bc;
        if (lane == 0) { scal[unit] = blast; scal[2048 + unit] = mloc; }
    }
    const float* cw = a.in[6]; const float* cb = a.in[7];
    u32x4 cu[4][4];
#pragma unroll
    for (int it = 0; it < 4; ++it) {
        const int which = it >> 1, l = (tid >> 4) + 32 * (it & 1), dg = tid & 15;
        const int ch = which * 512 + h * 128 + 8 * dg;
#pragma unroll
        for (int j = 0; j < 4; ++j) { const int sl = c * 64 + l - 3 + j;
            cu[it][j] = (sl >= 0) ? *(const u32x4*)(proj + ((size_t)b * SEQ + sl) * NIN + 1536 + ch) : (u32x4){0u, 0u, 0u, 0u}; }
    }
    u32x4 vu[2];
#pragma unroll
    for (int it = 0; it < 2; ++it) { const int l = (tid >> 4) + 32 * it, dg = tid & 15; vu[it] = *(const u32x4*)(proj + (row0 + l) * NIN + 2560 + h * 128 + 8 * dg); }
#pragma unroll
    for (int it = 0; it < 4; ++it) {
        const int which = it >> 1, l = (tid >> 4) + 32 * (it & 1), dg = tid & 15;
        const int ch = which * 512 + h * 128 + 8 * dg;
        float o[8];
#pragma unroll
        for (int e = 0; e < 8; ++e) o[e] = cb[ch + e];
#pragma unroll
        for (int j = 0; j < 4; ++j) { const u32x4 u = cu[it][j];
            const f32x4 w0 = *(const f32x4*)(cw + j * 1024 + ch), w1 = *(const f32x4*)(cw + j * 1024 + ch + 4);
            o[0] += __uint_as_float(u.x << 16) * w0[0]; o[1] += __uint_as_float(u.x & 0xffff0000u) * w0[1];
            o[2] += __uint_as_float(u.y << 16) * w0[2]; o[3] += __uint_as_float(u.y & 0xffff0000u) * w0[3];
            o[4] += __uint_as_float(u.z << 16) * w1[0]; o[5] += __uint_as_float(u.z & 0xffff0000u) * w1[1];
            o[6] += __uint_as_float(u.w << 16) * w1[2]; o[7] += __uint_as_float(u.w & 0xffff0000u) * w1[3]; }
        const float sc = which ? KSCALE : 1.f;
#pragma unroll
        for (int e = 0; e < 8; ++e) o[e] = o[e] * fsigmoid(o[e]) * sc;
        u32x4 w; w.x = cvtpk(o[0], o[1]); w.y = cvtpk(o[2], o[3]); w.z = cvtpk(o[4], o[5]); w.w = cvtpk(o[6], o[7]);
        bf16_t* dst = (bf16_t*)(ws + (which ? WS_MK : WS_MQ)) + (row0 + l) * 512 + h * 128 + 8 * dg;
        *(u32x4*)dst = w;
        if (which) {
#pragma unroll
            for (int e = 0; e < 8; ++e) Kt[(8 * dg + e) * 72 + l] = f2bf(o[e]);
        }
    }
    SYNC();
#pragma unroll
    for (int it = 0; it < 2; ++it) {
        const int l = (tid >> 4) + 32 * it, dg = tid & 15;
        const u32x4 u = vu[it];
        const float w = wl[l];
        float v[8] = {__uint_as_float(u.x << 16), __uint_as_float(u.x & 0xffff0000u), __uint_as_float(u.y << 16), __uint_as_float(u.y & 0xffff0000u),
                      __uint_as_float(u.z << 16), __uint_as_float(u.z & 0xffff0000u), __uint_as_float(u.w << 16), __uint_as_float(u.w & 0xffff0000u)};
#pragma unroll
        for (int e = 0; e < 8; ++e) Vw[(8 * dg + e) * 72 + l] = f2bf(v[e] * w);
    }
    SYNC();
    {
        const int vb = wid >> 1, kb0 = 2 * (wid & 1);
        bf16_t* kv = (bf16_t*)(ws + WS_KV) + (size_t)unit * 16384;
#pragma unroll
        for (int kk = 0; kk < 2; ++kk) { const int kb = kb0 + kk; f32x16 acc = {};
#pragma unroll
            for (int ks = 0; ks < 4; ++ks) { const bf16x8 A = *(const LAS bf16x8*)(Vw + (32 * vb + l32) * 72 + 16 * ks + 8 * hi); const bf16x8 B = *(const LAS bf16x8*)(Kt + (32 * kb + l32) * 72 + 16 * ks + 8 * hi);
                acc = MFMA32(A, B, acc); }
#pragma unroll
            for (int r = 0; r < 16; ++r) kv[(32 * vb + crow(r, hi)) * 128 + 32 * kb + l32] = f2bf(acc[r]); }
    }
    if (tid < 128) { float s = 0.f;
#pragma unroll 8
        for (int l = 0; l < 64; ++l) s += wl[l] * bf2f(Kt[tid * 72 + l]);
        ((float*)(ws + WS_NLOC))[(size_t)unit * 128 + tid] = s; }
    SYNC();
}
__device__ __forceinline__ void vt_unit(const Args& a, LAS unsigned char* lds, int tv) {
    const int tid = threadIdx.x;
    LAS bf16_t* T = (LAS bf16_t*)lds;
    const bf16_t* proj = (const bf16_t*)(a.ws + WS_BIG);
    const size_t r0 = (size_t)tv * 64; const int b = tv >> 8, s0 = (tv & 255) * 64;
#pragma unroll
    for (int i = 0; i < 8; ++i) { const int id = tid + 512 * i, row = id >> 6, ch = id & 63;
        *(LAS u32x4*)(T + row * 520 + 8 * ch) = *(const u32x4*)(proj + (r0 + row) * NIN + 1024 + 8 * ch); }
    SYNC();
    { const int h = tid >> 7, d = tid & 127;
      bf16_t* dst = (bf16_t*)(a.ws + WS_VT) + ((size_t)(b * 4 + h) * 128 + d) * VSTR + s0;
#pragma unroll
      for (int i = 0; i < 8; ++i) { unsigned w[4];
#pragma unroll
          for (int e = 0; e < 4; ++e) { const int k0 = 16 * (i >> 1) + 4 * (i & 1) + ((2 * e) & 3) + 8 * (e >> 1);
              w[e] = (unsigned)T[k0 * 520 + tid] | ((unsigned)T[(k0 + 1) * 520 + tid] << 16); }
          *(u32x4*)(dst + 8 * i) = (u32x4){w[0], w[1], w[2], w[3]}; } }
    SYNC();
}

__device__ __forceinline__ void ml_scan(const Args& a) {
    const int tid = threadIdx.x;
    unsigned char* ws = a.ws;
    const float* scal = (const float*)(ws + WS_SCAL);
    for (int g = blockIdx.x; g < 130; g += gridDim.x) {
        if (g < 128) {
            const int gid = g * 512 + tid, bh = gid >> 13, w = gid & 8191;
            unsigned* p = (unsigned*)(ws + WS_KV) + (size_t)bh * 256 * 8192 + w;
            float C0 = 0.f, C1 = 0.f, m = 0.f;
            for (int c0 = 0; c0 < 256; c0 += 8) {
                unsigned kv[8];
#pragma unroll
                for (int i = 0; i < 8; ++i) kv[i] = p[(size_t)(c0 + i) * 8192];
#pragma unroll
                for (int i = 0; i < 8; ++i) {
                    const float bl = scal[bh * 256 + c0 + i], ml = scal[2048 + bh * 256 + c0 + i];
                    const float mn = fmaxf(bl + m, ml), dec = expf(bl + m - mn), sc = expf(ml - mn);
                    p[(size_t)(c0 + i) * 8192] = cvtpk(C0, C1);
                    C0 = dec * C0 + sc * __uint_as_float(kv[i] << 16); C1 = dec * C1 + sc * __uint_as_float(kv[i] & 0xffff0000u); m = mn;
                }
            }
        } else {
            const int gid = (g - 128) * 512 + tid, bh = gid >> 7, k = gid & 127;
            float* p = (float*)(ws + WS_NLOC) + (size_t)bh * 256 * 128 + k;
            float* mprev = (float*)(ws + WS_SCAL) + 4096;
            float n = 0.f, m = 0.f;
            for (int c = 0; c < 256; ++c) {
                const float bl = scal[bh * 256 + c], ml = scal[2048 + bh * 256 + c];
                const float mn = fmaxf(bl + m, ml), dec = expf(bl + m - mn), sc = expf(ml - mn);
                const float nl = p[c * 128];
                p[c * 128] = n; if (k == 0) mprev[bh * 256 + c] = m;
                n = dec * n + sc * nl; m = mn;
            }
        }
    }
}

__device__ __forceinline__ void ml_out_phase(const Args& a, LAS unsigned char* lds) {
    const int tid = threadIdx.x, lane = tid & 63, wid = tid >> 6, l32 = lane & 31, hi = lane >> 5;
    unsigned char* ws = a.ws;
    LAS bf16_t* Qs = (LAS bf16_t*)lds;
    LAS bf16_t* Ks = (LAS bf16_t*)(lds + 17408);
    LAS bf16_t* Vt = (LAS bf16_t*)(lds + 34816);
    LAS bf16_t* Cs = (LAS bf16_t*)(lds + 53248);
    LAS float* Hs = (LAS float*)(lds + 88064);
    LAS float* bs = (LAS float*)(lds + 121856);
    LAS float* lis = bs + 64;
    LAS float* ns = bs + 128;
    LAS float* wsf = bs + 256 + wid * 64;
    const bf16_t* proj = (const bf16_t*)(ws + WS_BIG);
    const float* scal = (const float*)(ws + WS_SCAL);
    const int G = gridDim.x;
    int unit = blockIdx.x;
    if (unit >= 2048) return;
    u32x4 rq[2], rk[2], rv[2], rc[4]; float rs0 = 0.f, rs1 = 0.f, rmp;
#define MLO_LOAD(UU) do { const int _bh = (UU) >> 8, _c = (UU) & 255, _b = _bh >> 2, _h = _bh & 3; const size_t _r0 = (size_t)_b * SEQ + _c * 64; \
        _Pragma("unroll") for (int i = 0; i < 2; ++i) { const int id = tid + 512 * i, row = id >> 4, ch = id & 15; \
            rq[i] = *(const u32x4*)((const bf16_t*)(ws + WS_MQ) + (_r0 + row) * 512 + _h * 128 + 8 * ch); \
            rk[i] = *(const u32x4*)((const bf16_t*)(ws + WS_MK) + (_r0 + row) * 512 + _h * 128 + 8 * ch); \
            } \
        _Pragma("unroll") for (int i = 0; i < 4; ++i) { const int id = tid + 512 * i, row = id >> 4, ch = id & 15; \
            rc[i] = *(const u32x4*)((const bf16_t*)(ws + WS_KV) + (size_t)(UU) * 16384 + row * 128 + 8 * ch); } \
        if (tid < 64) { rs0 = scal[6144 + (size_t)_bh * SEQ + _c * 64 + tid]; rs1 = ((const float*)(ws + WS_GATE))[(_r0 + tid) * 8 + _h]; } \
        else if (tid < 192) { rs0 = ((const float*)(ws + WS_NLOC))[(size_t)(UU) * 128 + tid - 64]; } \
        rmp = scal[4096 + (UU)]; } while (0)
#define MLO_LOADV(UU) do { const int _bh = (UU) >> 8, _c = (UU) & 255, _b = _bh >> 2, _h = _bh & 3; const size_t _r0 = (size_t)_b * SEQ + _c * 64; \
        _Pragma("unroll") for (int i = 0; i < 2; ++i) { const int id = tid + 512 * i, row = id >> 4, ch = id & 15; rv[i] = *(const u32x4*)(proj + (_r0 + row) * NIN + 2560 + _h * 128 + 8 * ch); } } while (0)
    MLO_LOAD(unit); MLO_LOADV(unit);
    const float g0 = a.in[15][lane], g1 = a.in[15][lane + 64];
    for (; unit < 2048; unit += G) {
    int tq = threadIdx.x; asm volatile("" : "+v"(tq));
    const int tid = tq, lane = tid & 63, wid = tid >> 6, l32 = lane & 31, hi = lane >> 5;
    LAS float* wsf = bs + 256 + wid * 64;
    const int bh = unit >> 8, c = unit & 255, b = bh >> 2, h = bh & 3;
    const size_t row0 = (size_t)b * SEQ + c * 64;
#pragma unroll
    for (int i = 0; i < 4; ++i) { const int id = tid + 512 * i, row = id >> 4, ch = id & 15;
        *(LAS u32x4*)(Cs + row * 136 + 8 * ch) = rc[i]; }
#pragma unroll
    for (int i = 0; i < 2; ++i) { const int id = tid + 512 * i, row = id >> 4, ch = id & 15;
        *(LAS u32x4*)(Qs + row * 136 + 8 * ch) = rq[i];
        *(LAS u32x4*)(Ks + row * 136 + 8 * ch) = rk[i];
        const unsigned uu[4] = {rv[i].x, rv[i].y, rv[i].z, rv[i].w};
#pragma unroll
        for (int e = 0; e < 4; ++e) { Vt[(8 * ch + 2 * e) * 72 + row] = (bf16_t)(uu[e] & 0xffffu); Vt[(8 * ch + 2 * e + 1) * 72 + row] = (bf16_t)(uu[e] >> 16); } }
    if (tid < 64) { bs[tid] = rs0; lis[tid] = rs1; }
    else if (tid < 192) { ns[tid - 64] = rs0; }
    const float mprev = rmp;
    asm volatile("s_waitcnt lgkmcnt(0)" ::: "memory"); __builtin_amdgcn_s_barrier(); asm volatile("" ::: "memory");
    unsigned ogp[8];
#pragma unroll
    for (int i = 0; i < 8; ++i) { const bf16_t* op = proj + (row0 + 8 * wid + i) * NIN + 3072 + h * 128; ogp[i] = (unsigned)op[lane] | ((unsigned)op[lane + 64] << 16); }
    if (unit + G < 2048) MLO_LOAD(unit + G);
    const int jb = wid & 1, vb = wid >> 1, j = 32 * jb + l32;
    f32x16 st[2];
#pragma unroll
    for (int sb = 0; sb < 2; ++sb) { st[sb] = (f32x16){};
        if (sb <= jb) {
#pragma unroll
            for (int ks = 0; ks < 8; ++ks) { const bf16x8 A = *(const LAS bf16x8*)(Ks + (32 * sb + l32) * 136 + 16 * ks + 8 * hi); const bf16x8 B = *(const LAS bf16x8*)(Qs + (32 * jb + l32) * 136 + 16 * ks + 8 * hi);
                st[sb] = MFMA32(A, B, st[sb]); } } }
    __builtin_amdgcn_sched_barrier(0);
    __builtin_amdgcn_sched_barrier(0);
    const float bj = bs[j], m_inter = bj + mprev;
    float mx = -INFINITY;
#pragma unroll
    for (int sb = 0; sb < 2; ++sb)
#pragma unroll
        for (int r = 0; r < 16; ++r) { const int s = 32 * sb + crow(r, hi); const float dm = bj - bs[s] + lis[s]; mx = fmaxf(mx, (s <= j) ? dm : -INFINITY); }
    mx = fmaxf(mx, __shfl_xor(mx, 32));
    __builtin_amdgcn_sched_barrier(0);
    __builtin_amdgcn_sched_barrier(0);
    const float mj = fmaxf(m_inter, mx);
    float rowsum = 0.f; unsigned pk[2][8];
#pragma unroll
    for (int sb = 0; sb < 2; ++sb) { float sw[16];
#pragma unroll
        for (int r = 0; r < 16; ++r) { const int s = 32 * sb + crow(r, hi); const float ew = fexp(bj - bs[s] + lis[s] - mj); const float wgt = (s <= j) ? ew : 0.f; sw[r] = st[sb][r] * wgt; rowsum += sw[r]; }
#pragma unroll
        for (int e = 0; e < 8; ++e) pk[sb][e] = cvtpk(sw[2 * e], sw[2 * e + 1]);
        __builtin_amdgcn_sched_barrier(0); }
    rowsum += __shfl_xor(rowsum, 32);
    __builtin_amdgcn_sched_barrier(0);
    __builtin_amdgcn_sched_barrier(0);
    float nq = 0.f;
#pragma unroll
    for (int k8 = 0; k8 < 8; ++k8) { const u32x4 u = *(const LAS u32x4*)(Qs + j * 136 + 64 * hi + 8 * k8); const LAS float* np = ns + 64 * hi + 8 * k8;
        nq += __uint_as_float(u.x << 16) * np[0] + __uint_as_float(u.x & 0xffff0000u) * np[1] + __uint_as_float(u.y << 16) * np[2] + __uint_as_float(u.y & 0xffff0000u) * np[3]
            + __uint_as_float(u.z << 16) * np[4] + __uint_as_float(u.z & 0xffff0000u) * np[5] + __uint_as_float(u.w << 16) * np[6] + __uint_as_float(u.w & 0xffff0000u) * np[7]; }
    nq += __shfl_xor(nq, 32);
    __builtin_amdgcn_sched_barrier(0);
    __builtin_amdgcn_sched_barrier(0);
    const float inter_w = fexp(m_inter - mj);
    const float den = rowsum + inter_w * nq;
    const float dscale = 1.f / fmaxf(fabsf(den), fexp(-mj));
    if (hi == 0) { wsf[l32] = dscale; wsf[32 + l32] = inter_w * dscale; }
    asm volatile("s_waitcnt lgkmcnt(0)" ::: "memory");
    __builtin_amdgcn_sched_barrier(0);
    __builtin_amdgcn_sched_barrier(0);
    f32x16 a1 = {}, a2 = {};
#pragma unroll
    for (int sb = 0; sb < 2; ++sb)
        if (sb <= jb) {
#pragma unroll
            for (int jj = 0; jj < 2; ++jj) { const bf16x8 A = __builtin_bit_cast(bf16x8, (u32x4){pk[sb][4 * jj], pk[sb][4 * jj + 1], pk[sb][4 * jj + 2], pk[sb][4 * jj + 3]});
                const LAS bf16_t* vp = Vt + (32 * vb + l32) * 72 + 32 * sb + 16 * jj + 4 * hi;
                const u32x2 lo = *(const LAS u32x2*)vp, hi2 = *(const LAS u32x2*)(vp + 8);
                const bf16x8 B = __builtin_bit_cast(bf16x8, (u32x4){lo.x, lo.y, hi2.x, hi2.y});
                a1 = MFMA32(A, B, a1); } }
#pragma unroll
    for (int ks = 0; ks < 8; ++ks) { const bf16x8 A = *(const LAS bf16x8*)(Qs + (32 * jb + l32) * 136 + 16 * ks + 8 * hi); const bf16x8 B = *(const LAS bf16x8*)(Cs + (32 * vb + l32) * 136 + 16 * ks + 8 * hi);
        a2 = MFMA32(A, B, a2); }
#pragma unroll
    for (int r = 0; r < 16; ++r) { const int jr = crow(r, hi); Hs[(32 * jb + jr) * 132 + 32 * vb + l32] = a1[r] * wsf[jr] + a2[r] * wsf[32 + jr]; }
    asm volatile("s_waitcnt lgkmcnt(0)" ::: "memory"); __builtin_amdgcn_s_barrier(); asm volatile("" ::: "memory");
    if (unit + G < 2048) MLO_LOADV(unit + G);
    { bf16_t* mix = (bf16_t*)(ws + WS_XB);
#pragma unroll
      for (int i = 0; i < 8; ++i) { const int jr = 8 * wid + i; const float x0 = Hs[jr * 132 + lane], x1 = Hs[jr * 132 + lane + 64];
          const float mean = wave_sum(x0 + x1) * (1.f / 128.f); const float d0 = x0 - mean, d1 = x1 - mean;
          const float rstd = 1.f / sqrtf(wave_sum(d0 * d0 + d1 * d1) * (1.f / 128.f) + LN_EPS);
          const float o0 = __uint_as_float(ogp[i] << 16), o1 = __uint_as_float(ogp[i] & 0xffff0000u);
          bf16_t* mp = mix + (row0 + jr) * D + 512 + h * 128;
          mp[lane] = f2bf(d0 * rstd * g0 * fsigmoid(o0)); mp[lane + 64] = f2bf(d1 * rstd * g1 * fsigmoid(o1)); } }
    asm volatile("s_waitcnt lgkmcnt(0)" ::: "memory"); __builtin_amdgcn_s_barrier(); asm volatile("" ::: "memory");
    }
#undef MLO_LOAD
#undef MLO_LOADV
}

namespace att {
constexpr int SLOT = 32768, NSLOT = 4, OFF_TAB = NSLOT * SLOT, OFF_WSF = OFF_TAB + 1024, OFF_BC = OFF_WSF + 2048;
constexpr float THR = 12.f;
#define ATT_WAIT_V(n) asm volatile("s_waitcnt vmcnt(" #n ")" ::: "memory")
#define ATT_BAR() do { asm volatile("s_waitcnt lgkmcnt(0)" ::: "memory"); __builtin_amdgcn_s_barrier(); asm volatile("" ::: "memory"); } while (0)

__device__ __forceinline__ float max3f(float a, float b, float c) { float r; asm("v_max3_f32 %0, %1, %2, %3" : "=v"(r) : "v"(a), "v"(b), "v"(c)); return r; }
__device__ __forceinline__ float sm_pre(f32x16& s, bool near, LAS const float* tp, float ref, bool first, float& mhat, float& lsum, f32x16 (&o)[4], LAS float* wsf, int l32, int hi) {
    if (near) {
#pragma unroll
        for (int r = 0; r < 16; ++r) s[r] += tp[(r & 3) + 8 * (r >> 2)];
    }
    float rm = max3f(s[0], s[1], s[2]); float rm2 = max3f(s[3], s[4], s[5]);
    rm = max3f(rm, s[6], s[7]); rm2 = max3f(rm2, s[8], s[9]); rm = max3f(rm, s[10], s[11]); rm2 = max3f(rm2, s[12], s[13]); rm = max3f(rm, s[14], s[15]);
    rm = max3f(rm, rm2, rm2);
    { auto rr = __builtin_amdgcn_permlane32_swap(__float_as_uint(rm), __float_as_uint(rm), false, false); rm = max3f(__uint_as_float(rr[0]), __uint_as_float(rr[1]), rm); }
    rm += ref - mhat;
    if (first) asm volatile("s_nop 0");
    if (__any(rm > THR)) {
        const float dl = fmaxf(rm, 0.f);
        mhat += dl;
        {
            const float f = __builtin_amdgcn_exp2f(-dl);
            lsum *= f;
            if (hi == 0) wsf[l32] = f;
            asm volatile("s_waitcnt lgkmcnt(0)" ::: "memory");
#pragma unroll
            for (int r4 = 0; r4 < 4; ++r4) { const f32x4 fv = *(const LAS f32x4*)(wsf + 8 * r4 + 4 * hi);
#pragma unroll
                for (int d = 0; d < 4; ++d) { o[d][4 * r4] *= fv[0]; o[d][4 * r4 + 1] *= fv[1]; o[d][4 * r4 + 2] *= fv[2]; o[d][4 * r4 + 3] *= fv[3]; } }
            asm volatile("s_waitcnt lgkmcnt(0)" ::: "memory");
        }
    }
    return ref - mhat;
}
__device__ __forceinline__ float fadd_s(float a, float b) { float r; asm("v_add_f32_e32 %0, %1, %2" : "=v"(r) : "v"(a), "v"(b)); return r; }
__device__ __forceinline__ void sm_exp(f32x16& s, float nsub, float& lsum, unsigned (&pk)[8]) {
    if (__any(nsub != 0.f)) {
#pragma unroll
        for (int r = 0; r < 16; ++r) s[r] += nsub;
    }
    float p0 = 0.f, p1 = 0.f, p2 = 0.f, p3 = 0.f;
#pragma unroll
    for (int r = 0; r < 16; r += 4) { const float a = __builtin_amdgcn_exp2f(s[r]), b = __builtin_amdgcn_exp2f(s[r + 1]), c = __builtin_amdgcn_exp2f(s[r + 2]), d = __builtin_amdgcn_exp2f(s[r + 3]);
        p0 = fadd_s(p0, a); p1 = fadd_s(p1, b); p2 = fadd_s(p2, c); p3 = fadd_s(p3, d);
        pk[r / 2] = cvtpk(a, b); pk[r / 2 + 1] = cvtpk(c, d); }
    lsum = fadd_s(lsum, fadd_s(fadd_s(p0, p1), fadd_s(p2, p3)));
}

__device__ __forceinline__ void attn_unit(const Args& a, LAS unsigned char* lds, float lam, int bh, int qb) {
    const int tid = threadIdx.x, lane = tid & 63, wid = __builtin_amdgcn_readfirstlane(tid >> 6), l32 = lane & 31, hi = lane >> 5;
    const int mp = wid >> 2, rg = wid & 3;
    const int b = bh >> 2, h = bh & 3;
    unsigned char* ws = a.ws;
    const bf16_t* proj = (const bf16_t*)(ws + WS_BIG);
    const bf16_t* VtG = (const bf16_t*)(ws + WS_VT);
    LAS float* tab = (LAS float*)(lds + OFF_TAB);
    LAS float* wsf = (LAS float*)(lds + OFF_WSF) + wid * 64;
    const size_t rowb = (size_t)b * SEQ;
    ATT_WAIT_V(0);
    if (tid < 256) { const int rel = tid - 191; const int n = rel < 0 ? -rel : rel; int bucket;
        if (n < 8) bucket = n; else { int lg = 31 - __clz(n * n); bucket = 2 + lg; if (bucket > 15) bucket = 15; }
        if (rel > 0) bucket += 16;
        tab[tid] = (a.in[23][bucket * 4 + h] - a.in[23][15 * 4 + h]) * LOG2E; }
    const int kvr = tid >> 3, kc = (tid & 7) ^ ((kvr >> 1) & 7);
    const bf16_t* ksrc = proj + (rowb + kvr) * NIN + 512 + h * 128 + 8 * kc;
    const bf16_t* vsrc = VtG + ((size_t)bh * 128 + kvr) * VSTR + 8 * kc;
#define ATT_ISSUE(t, slot) do { LAS unsigned char* _d = lds + (slot) * SLOT + wid * 1024; const bf16_t* _k = ksrc + (size_t)(t) * 64 * NIN; const bf16_t* _v = vsrc + (t) * 64; \
        __builtin_amdgcn_global_load_lds((const unsigned*)_k, (LAS unsigned*)_d, 16, 0, 0); \
        __builtin_amdgcn_global_load_lds((const unsigned*)(_k + 64), (LAS unsigned*)(_d + 8192), 16, 0, 0); \
        __builtin_amdgcn_global_load_lds((const unsigned*)_v, (LAS unsigned*)(_d + 16384), 16, 0, 0); \
        __builtin_amdgcn_global_load_lds((const unsigned*)(_v + (size_t)64 * VSTR), (LAS unsigned*)(_d + 24576), 16, 0, 0); } while (0)
    const int qrow = 128 * qb + 32 * rg + l32;
    bf16x8 qf[4];
    { const bf16_t* qp = proj + (rowb + qrow) * NIN + h * 128 + 64 * mp + 8 * hi;
#pragma unroll
      for (int d0 = 0; d0 < 4; ++d0) qf[d0] = *(const bf16x8*)(qp + 16 * d0); }
    const int NT = 2 * qb + 2, cq = 2 * qb + (rg >> 1);
    ATT_ISSUE(0, 0); ATT_ISSUE(1, 1); if (NT > 2) ATT_ISSUE(2, 2);
    f32x16 o[4];
#pragma unroll
    for (int d = 0; d < 4; ++d) o[d] = (f32x16){};
    float mhat = 0.f, lsum = 0.f;
#define ATT_KLD(tt, blk, KN) do { \
        int _sw = ((l32 >> 1) & 7) << 4; asm volatile("" : "+v"(_sw)); const int _xo = _sw ^ (hi << 4); \
        LAS const unsigned char* _kb = lds + ((tt) & 3) * SLOT + mp * 8192 + (blk) * 4096 + l32 * 128; \
        _Pragma("unroll") for (int d0 = 0; d0 < 4; ++d0) KN[d0] = *(const LAS bf16x8*)(_kb + (_xo ^ (d0 << 5))); } while (0)
#define ATT_SMM(KN, S) do { S = MFMA32(KN[0], qf[0], ((f32x16){})); _Pragma("unroll") for (int d0 = 1; d0 < 4; ++d0) S = MFMA32(KN[d0], qf[d0], S); } while (0)
#define ATT_S1(tt, blk, S) do { bf16x8 _kk[4]; ATT_KLD(tt, blk, _kk); ATT_SMM(_kk, S); } while (0)
#define ATT_VLD(DST, c) do { _Pragma("unroll") for (int d = 0; d < 4; ++d) DST[d] = *(const LAS bf16x8*)(_vb + d * 4096 + (_xv ^ ((c) << 4))); } while (0)
#define ATT_PV1(PK, jj, VF) do { const bf16x8 _P = __builtin_bit_cast(bf16x8, (u32x4){PK[4 * (jj)], PK[4 * (jj) + 1], PK[4 * (jj) + 2], PK[4 * (jj) + 3]}); \
        _Pragma("unroll") for (int d = 0; d < 4; ++d) o[d] = MFMA32(_P, VF[d], o[d]); } while (0)
#define ATT_FENCE() __builtin_amdgcn_sched_barrier(0)
#if 0
#define SCHED_A() do { _Pragma("unroll") for (int _i = 0; _i < 4; ++_i) { __builtin_amdgcn_sched_group_barrier(0x008, 1, 0); __builtin_amdgcn_sched_group_barrier(0x002, 12, 0); } } while (0)
#else
#define SCHED_A() do {} while (0)
#endif
    f32x16 sX, sY;
    if (NT > 2) ATT_WAIT_V(8); else ATT_WAIT_V(4);
    ATT_BAR();
    ATT_S1(0, 0, sX);
    for (int t = 0; t < NT; ++t) {
        if (t + 3 <= NT) ATT_WAIT_V(4); else ATT_WAIT_V(0);
        ATT_BAR();
        if (t + 3 < NT) ATT_ISSUE(t + 3, (t + 3) & 3);
        if (t <= cq) {
            const bool near = (t >= cq - 2);
            int _swv = ((l32 >> 1) & 7) << 4; asm volatile("" : "+v"(_swv)); const int _xv = _swv ^ (hi << 4);
            LAS const unsigned char* _vb = lds + (t & 3) * SLOT + 16384 + l32 * 128;
            int relb = 64 * t - qrow + 191 + 4 * hi; asm volatile("" : "+v"(relb));
            LAS const float* tp = tab + relb;
            bf16x8 va[4], vc[4]; unsigned pk[8];
            const float ref = 0.f;
            bf16x8 kn[4];
            ATT_VLD(va, 0); ATT_VLD(vc, 2); ATT_KLD(t, 1, kn);
            const float nsX = sm_pre(sX, near, tp, ref, t == 0, mhat, lsum, o, wsf, l32, hi);
            ATT_FENCE();
            ATT_SMM(kn, sY);
            sm_exp(sX, nsX, lsum, pk);
            SCHED_A();
            ATT_FENCE();
            ATT_PV1(pk, 0, va); ATT_PV1(pk, 1, vc);
            ATT_FENCE();
            ATT_VLD(va, 4); ATT_VLD(vc, 6); ATT_KLD(t + 1, 0, kn);
            const float nsY = sm_pre(sY, near, tp + 32, ref, false, mhat, lsum, o, wsf, l32, hi);
            ATT_FENCE();
            ATT_SMM(kn, sX);
            sm_exp(sY, nsY, lsum, pk);
            SCHED_A();
            ATT_FENCE();
            ATT_PV1(pk, 0, va); ATT_PV1(pk, 1, vc);
            ATT_FENCE();
        }
    }
    int opq = 0; asm volatile("" : "+v"(opq));
    lsum += __shfl_xor(lsum, 32);
    if (hi == 0) wsf[l32] = (mp ? lam : 1.f) / lsum;
    asm volatile("s_waitcnt lgkmcnt(0)" ::: "memory");
#pragma unroll
    for (int r = 0; r < 16; ++r) { const float f = wsf[crow(r, hi)];
#pragma unroll
        for (int d = 0; d < 4; ++d) o[d][r] *= f; }
    ATT_BAR();
    LAS float* xch = (LAS float*)lds + rg * 4096 + lane + opq;
    if (mp == 1) {
#pragma unroll
        for (int d = 0; d < 4; ++d)
#pragma unroll
            for (int r = 0; r < 16; ++r) xch[(d * 16 + r) * 64] = o[d][r];
    }
    ATT_BAR();
    if (mp == 0) {
        float ss[16];
#pragma unroll
        for (int r = 0; r < 16; ++r) { float acc = 0.f;
#pragma unroll
            for (int d = 0; d < 4; ++d) { const float v = o[d][r] - xch[(d * 16 + r) * 64]; o[d][r] = v; acc += v * v; }
            ss[r] = acc; }
#pragma unroll
        for (int r = 0; r < 16; ++r) {
            ss[r] = half32_sum(ss[r]);
            ss[r] = (1.f - LAMBDA_INIT) / sqrtf(ss[r] * (1.f / 128.f) + LN_EPS); }
        bf16_t* mix = (bf16_t*)(ws + WS_XB) + (rowb + 128 * qb + 32 * rg) * D + h * 128 + opq;
        float gd[4];
#pragma unroll
        for (int d = 0; d < 4; ++d) gd[d] = a.in[14][32 * d + l32 + opq];
#pragma unroll
        for (int r = 0; r < 16; ++r)
#pragma unroll
            for (int d = 0; d < 4; ++d) mix[(size_t)crow(r, hi) * D + 32 * d + l32] = f2bf(o[d][r] * ss[r] * gd[d]);
    }
    ATT_BAR();
}
}

#define XB_TMO      128
#define XB_XCNT(j)  (256  + 64 * (j))
#define XB_XSUB(j)  (1280 + 64 * (j))
#define XB_XGEN(j)  (2304 + 64 * (j))
#define XB_TOP      3328
#define XB_TOPGEN   3392
#define XCD_BAR_WORDS 3456
#define XB_SPIN_CAP (1u << 20)
__device__ __forceinline__ unsigned xb_ld(unsigned* p)              { return __hip_atomic_load(p, __ATOMIC_RELAXED, __HIP_MEMORY_SCOPE_AGENT); }
__device__ __forceinline__ unsigned xb_add(unsigned* p, unsigned v) { return __hip_atomic_fetch_add(p, v, __ATOMIC_RELAXED, __HIP_MEMORY_SCOPE_AGENT); }
__device__ __forceinline__ unsigned xb_xcc_id() { return (unsigned)__builtin_amdgcn_s_getreg((3 << 11) | 20) & 0xFu; }
#define XB_SPIN(cond, bar) do { unsigned _sp = 0; while (cond) { __builtin_amdgcn_s_sleep(1); \
    if ((++_sp & 255u) == 0u) { if (xb_ld(&(bar)[XB_TMO])) break; if (_sp > XB_SPIN_CAP) { atomicAdd(&(bar)[XB_TMO], 1u); break; } } } } while (0)
struct XcdBarrier { unsigned* bar; unsigned x; volatile LAS unsigned* st; };
__device__ __forceinline__ XcdBarrier xcd_barrier_post(unsigned* bar, volatile LAS unsigned* st) {
    XcdBarrier b; b.bar = bar; b.x = xb_xcc_id(); b.st = st;
    if (threadIdx.x == 0) (void)xb_add(&bar[XB_XCNT(b.x)], 1u);
    return b;
}
__device__ __forceinline__ void xcd_barrier_complete(unsigned* bar, unsigned x, unsigned& nloc, unsigned& nx) {
    const unsigned G = gridDim.x * gridDim.y * gridDim.z;
    unsigned sum, cnt, mine, sp = 0u;
    for (;;) {
        sum = 0u; cnt = 0u; mine = 0u;
#pragma unroll
        for (unsigned j = 0; j < 16; ++j) { const unsigned c = xb_ld(&bar[XB_XCNT(j)]); sum += c; cnt += (c > 0u) ? 1u : 0u; mine = (j == x) ? c : mine; }
        if (sum == G) break;
        __builtin_amdgcn_s_sleep(1);
        if ((++sp & 255u) == 0u) { if (xb_ld(&bar[XB_TMO])) break; if (sp > XB_SPIN_CAP) { atomicAdd(&bar[XB_TMO], 1u); break; } }
    }
    nloc = mine > 0u ? mine : 1u; nx = cnt > 0u ? cnt : 1u;
}
__device__ __forceinline__ void xcd_barrier(const XcdBarrier& b) {
    asm volatile("s_waitcnt vmcnt(0)" ::: "memory");
    __syncthreads();
    if (threadIdx.x == 0) {
        unsigned* bar = b.bar;
        __builtin_amdgcn_s_waitcnt(0);
        unsigned nloc = b.st[0], nx = b.st[1];
        if (nloc == 0u) { xcd_barrier_complete(bar, b.x, nloc, nx); b.st[0] = nloc; b.st[1] = nx; }
        const unsigned old = xb_add(&bar[XB_XSUB(b.x)], 1u);
        const unsigned gen = old / nloc;
        if (old + 1u == (gen + 1u) * nloc) {
            __builtin_amdgcn_fence(__ATOMIC_RELEASE, "agent");
            asm volatile("s_waitcnt vmcnt(0)" ::: "memory");
            const unsigned og = xb_add(&bar[XB_TOP], 1u);
            const unsigned tg = og / nx;
            if (og + 1u == (tg + 1u) * nx) xb_add(&bar[XB_TOPGEN], 1u);
            else XB_SPIN(xb_ld(&bar[XB_TOPGEN]) == tg, bar);
            __builtin_amdgcn_fence(__ATOMIC_ACQUIRE, "agent");
            xb_add(&bar[XB_XGEN(b.x)], 1u);
            asm volatile("s_waitcnt vmcnt(0)" ::: "memory");
        } else {
            XB_SPIN(xb_ld(&bar[XB_XGEN(b.x)]) == gen, bar);
            __builtin_amdgcn_fence(__ATOMIC_ACQUIRE, "agent");
            asm volatile("s_waitcnt vmcnt(0)" ::: "memory");
        }
    }
    __syncthreads();
}

__global__ void __launch_bounds__(512) fwd_kernel(Args a) {
    extern __shared__ __attribute__((aligned(16))) unsigned char lds_raw[];
    LAS unsigned char* lds = (LAS unsigned char*)lds_raw;
    unsigned char* ws = a.ws;
    const int G = gridDim.x, bx = blockIdx.x;
    float* hbuf = a.out;
    const int lo = a.ph_lo, hi = a.ph_hi;
#ifndef PHMASK
#define PHMASK 0x1fff
#endif
#define IN(k) (((PHMASK >> (k)) & 1) && lo <= (k) && (k) < hi)
    volatile LAS unsigned* xst = (volatile LAS unsigned*)(lds + LDS_BYTES - 16);
    XcdBarrier xbar; xbar.bar = (unsigned*)(ws + 65536); xbar.x = 0; xbar.st = xst;
    bool xposted = false;
#define SEAM(k) do { if ((k) + 1 < hi) { if ((k) == 0) { __syncthreads(); cg::this_grid().sync(); } \
        else { if (!xposted) { if (threadIdx.x == 0) { xst[0] = 0u; xst[1] = 0u; } __syncthreads(); xbar = xcd_barrier_post((unsigned*)(ws + 65536), xst); xposted = true; } xcd_barrier(xbar); } } } while (0)
    if (IN(0)) { if (bx == 0) { if (threadIdx.x < 8) ((unsigned*)ws)[64 * threadIdx.x] = 0u; for (int i = threadIdx.x; i < XCD_BAR_WORDS; i += 512) ((unsigned*)(ws + 65536))[i] = 0u; }
                 p0_prologue(a, lds); SEAM(0); }
    if (IN(1)) { pg8::Gemm g{(const bf16_t*)(ws + WS_XB), (const bf16_t*)(ws + WS_WUP1), M, NUP, D}; pg8::StaticOrder S; S.init(M, NUP, G, bx);
                 pg8::EpiSwiGLU E{(bf16_t*)(ws + WS_BIG), FF}; pg8::gemm_phase(lds, g, S, E); SEAM(1); }
    if (IN(2)) { pg8::Gemm g{(const bf16_t*)(ws + WS_BIG), (const bf16_t*)(ws + WS_WD1), M, D, FF}; pg8::StaticOrder S; S.init(M, D, G, bx);
                 pg8::EpiResid E{a.in[0], hbuf, ALPHA, 0.5f}; pg8::gemm_phase(lds, g, S, E); SEAM(2); }
    if (IN(3)) { ln_phase<true, true>(a, lds, hbuf, a.in[1], a.in[2]); SEAM(3); }
    if (IN(4)) { pg8::Gemm g{(const bf16_t*)(ws + WS_XB), (const bf16_t*)(ws + WS_WIN), M, NIN, D}; pg8::StaticOrder S; S.init(M, NIN, G, bx);
                 pg8::EpiBf16 E{(bf16_t*)(ws + WS_BIG), NIN}; pg8::gemm_phase(lds, g, S, E); SEAM(4); }
    if (IN(5)) { for (int u = bx; u < 2048 + 512; u += G) { if (u < 2048) ml_pre_unit(a, lds, u); else vt_unit(a, lds, u - 2048); } SEAM(5); }
    if (IN(6)) {
        ml_scan(a);
        float lam;
        { float s1 = 0.f, s2 = 0.f;
          for (int i = 0; i < 64; ++i) { s1 += a.in[10][i] * a.in[11][i]; s2 += a.in[12][i] * a.in[13][i]; }
          lam = expf(s1) - expf(s2) + LAMBDA_INIT; }
        unsigned* ctr = (unsigned*)ws;
        LAS int* bc = (LAS int*)(lds + att::OFF_BC);
        const int my = (int)(__builtin_amdgcn_s_getreg((3 << 11) | 20) & 7u);
        for (int k = 0; k < 8; ++k) { const int bh = (my + k) & 7;
            for (;;) { if (threadIdx.x == 0) *bc = (int)atomicAdd(ctr + 64 * bh, 1u);
                SYNC(); const int idx = *bc; SYNC();
                if (idx >= 128) break;
                att::attn_unit(a, lds, lam, bh, 127 - idx); } }
        SEAM(6);
    }
    if (IN(7)) {
        ml_out_phase(a, lds);
        SEAM(7);
    }
    if (IN(8)) { pg8::Gemm g{(const bf16_t*)(ws + WS_XB), (const bf16_t*)(ws + WS_WOUT), M, D, D}; pg8::StaticOrder S; S.init(M, D, G, bx);
                 pg8::EpiResid E{hbuf, hbuf, ALPHA, 1.0f}; pg8::gemm_phase(lds, g, S, E); SEAM(8); }
    if (IN(9)) { ln_phase<true, false>(a, lds, hbuf, a.in[17], a.in[18]); SEAM(9); }
    if (IN(10)) { pg8::Gemm g{(const bf16_t*)(ws + WS_XB), (const bf16_t*)(ws + WS_WUP2), M, NUP, D}; pg8::StaticOrder S; S.init(M, NUP, G, bx);
                  pg8::EpiSwiGLU E{(bf16_t*)(ws + WS_BIG), FF}; pg8::gemm_phase(lds, g, S, E); SEAM(10); }
    if (IN(11)) { pg8::Gemm g{(const bf16_t*)(ws + WS_BIG), (const bf16_t*)(ws + WS_WD2), M, D, FF}; pg8::StaticOrder S; S.init(M, D, G, bx);
                  pg8::EpiResid E{hbuf, hbuf, ALPHA, 0.5f}; pg8::gemm_phase(lds, g, S, E); SEAM(11); }
    if (IN(12)) { ln_phase<false, false>(a, lds, hbuf, a.in[21], a.in[22]); }
}

constexpr int N_PHASES = 13;

extern "C" void kernel_launch(void* const* d_in, const int* in_sizes, int n_in, void* d_out, int out_size, void* d_ws, size_t ws_size, hipStream_t stream) {
    static int grid = 0;
    if (grid == 0) {
        if (n_in != 24 || out_size != M * D || ws_size < WS_END) { fprintf(stderr, "kernel_launch: unexpected shapes n_in %d out %d ws %zu\n", n_in, out_size, ws_size); grid = -1; return; }
        int dev = 0, cus = 0, per_cu = 0;
        hipGetDevice(&dev);
        hipDeviceGetAttribute(&cus, hipDeviceAttributeMultiprocessorCount, dev);
        if (hipFuncSetAttribute((const void*)fwd_kernel, hipFuncAttributeMaxDynamicSharedMemorySize, LDS_BYTES) != hipSuccess) { fprintf(stderr, "hipFuncSetAttribute failed\n"); }
        hipOccupancyMaxActiveBlocksPerMultiprocessor(&per_cu, (const void*)fwd_kernel, 512, LDS_BYTES);
        (void)hipGetLastError();
        if (per_cu < 1) per_cu = 1;
        grid = cus * per_cu;
        if (grid > 256) grid = 256;
    }
    if (grid < 0) return;
    Args a{};
    for (int i = 0; i < 24; ++i) a.in[i] = (const float*)d_in[i];
    a.out = (float*)d_out; a.ws = (unsigned char*)d_ws;
#if ONE_LAUNCH
    a.ph_lo = 0; a.ph_hi = N_PHASES;
    void* args[] = {&a};
    hipError_t e = hipLaunchCooperativeKernel((const void*)fwd_kernel, dim3(grid), dim3(512), args, LDS_BYTES, stream);
    if (e != hipSuccess) fprintf(stderr, "cooperative launch failed: %s (grid %d)\n", hipGetErrorString(e), grid);
#else
    for (int ph = 0; ph < N_PHASES; ++ph) { a.ph_lo = ph; a.ph_hi = ph + 1;
        hipLaunchKernelGGL(fwd_kernel, dim3(grid), dim3(512), LDS_BYTES, stream, a); }
#endif
}
```

```cpp
#include <hip/hip_runtime.h>
#include <hip/hip_cooperative_groups.h>
#include <cstdio>
#include <cstdint>
namespace cg = cooperative_groups;

#ifndef ONE_LAUNCH
#define ONE_LAUNCH 1
#endif

#define LAS __attribute__((address_space(3)))
typedef unsigned short bf16_t;
typedef short bf16x8 __attribute__((ext_vector_type(8)));
typedef short s16x4 __attribute__((ext_vector_type(4)));
typedef float f32x4 __attribute__((ext_vector_type(4)));
typedef float f32x2 __attribute__((ext_vector_type(2)));
typedef float f32x16 __attribute__((ext_vector_type(16)));
typedef unsigned u32x4 __attribute__((ext_vector_type(4)));
typedef unsigned u32x2 __attribute__((ext_vector_type(2)));
typedef __bf16 bf16x2_t __attribute__((ext_vector_type(2)));

constexpr int SEQ = 16384, BATCH = 2, M = BATCH * SEQ, D = 1024, FF = 2816, NUP = 2 * FF, NIN = 3584, INC = 3592;
constexpr float LN_EPS = 1e-5f;
constexpr float ALPHA = 1.189207115002721f;
constexpr float LOG2E = 1.4426950408889634f;
constexpr float QSCALE = 0.125f * LOG2E;
constexpr float KSCALE = 0.08838834764831845f;
constexpr float LAMBDA_INIT = 0.2f;

constexpr size_t MiB = 1u << 20;
constexpr size_t WS_WUP1 = 1 * MiB, WS_WD1 = 12 * MiB, WS_WIN = 18 * MiB, WS_WOUT = 25 * MiB, WS_WUP2 = 27 * MiB, WS_WD2 = 38 * MiB;
constexpr size_t WS_WG = 44 * MiB;
constexpr size_t WS_GATE = 45 * MiB;
constexpr size_t WS_NLOC = 46 * MiB;
constexpr size_t WS_SCAL = 47 * MiB;
constexpr size_t WS_XB = 48 * MiB;
constexpr size_t WS_BIG = 112 * MiB;
constexpr size_t WS_MQ = 336 * MiB, WS_MK = 368 * MiB;
constexpr size_t WS_KV = 400 * MiB;
constexpr size_t WS_VT = 464 * MiB;
constexpr size_t WS_END = 498 * MiB;
constexpr int VSTR = SEQ + 64;

constexpr int LDS_BYTES = 147456;

__device__ __forceinline__ float bf2f(bf16_t x) { return __uint_as_float(((unsigned)x) << 16); }
__device__ __forceinline__ unsigned cvtpk(float lo, float hi) { f32x2 v = {lo, hi}; bf16x2_t b = __builtin_convertvector(v, bf16x2_t); return __builtin_bit_cast(unsigned, b); }
__device__ __forceinline__ bf16_t f2bf(float f) { return (bf16_t)(cvtpk(f, 0.f) & 0xffffu); }
#define DPPF(v, ctrl) __builtin_bit_cast(float, __builtin_amdgcn_update_dpp(0, __builtin_bit_cast(int, (v)), (ctrl), 0xF, 0xF, true))
__device__ __forceinline__ float row16_sum(float v) {
    v += DPPF(v, 0xB1);  v += DPPF(v, 0x4E);  v += DPPF(v, 0x141);  v += DPPF(v, 0x140);
    return v;
}
__device__ __forceinline__ float half32_sum(float v) {
    v = row16_sum(v);
    auto rr = __builtin_amdgcn_permlane16_swap(__float_as_uint(v), __float_as_uint(v), false, false);
    return __uint_as_float(rr[0]) + __uint_as_float(rr[1]);
}
__device__ __forceinline__ float wave_sum(float v) {
    v = half32_sum(v);
    auto rr = __builtin_amdgcn_permlane32_swap(__float_as_uint(v), __float_as_uint(v), false, false);
    return __uint_as_float(rr[0]) + __uint_as_float(rr[1]);
}
__device__ __forceinline__ float wave_max(float v) {
    v = fmaxf(v, DPPF(v, 0xB1)); v = fmaxf(v, DPPF(v, 0x4E)); v = fmaxf(v, DPPF(v, 0x141)); v = fmaxf(v, DPPF(v, 0x140));
    { auto rr = __builtin_amdgcn_permlane16_swap(__float_as_uint(v), __float_as_uint(v), false, false); v = fmaxf(__uint_as_float(rr[0]), __uint_as_float(rr[1])); }
    { auto rr = __builtin_amdgcn_permlane32_swap(__float_as_uint(v), __float_as_uint(v), false, false); v = fmaxf(__uint_as_float(rr[0]), __uint_as_float(rr[1])); }
    return v;
}
__device__ __forceinline__ float fexp(float x) { return __builtin_amdgcn_exp2f(x * LOG2E); }
__device__ __forceinline__ float fsigmoid(float x) { return __builtin_amdgcn_rcpf(1.f + __builtin_amdgcn_exp2f(-x * LOG2E)); }
__device__ __forceinline__ int crow(int r, int hi) { return (r & 3) + 8 * (r >> 2) + 4 * hi; }
#define MFMA32(a, b, c) __builtin_amdgcn_mfma_f32_32x32x16_bf16((a), (b), (c), 0, 0, 0)

namespace pg8 {
constexpr int BM = 256, BK = 64, HALF = 128, HTB = HALF * BK * 2, STAGE_BYTES = 8 * HTB, NXCD = 8, WGM = 8;
__host__ __device__ __forceinline__ int lds_byte(int r, int c) { const int st = (r >> 4) * 2 + (c >> 5), rr = r & 15, cc = c & 31, ob = rr * 64 + cc * 2; return st * 1024 + (ob ^ (((ob >> 9) & 1) << 5)); }
__host__ __device__ __forceinline__ void stage_rc(int b, int& R, int& C) { const int st = b / 1024, sb = b % 1024, swz = sb ^ (((sb >> 9) & 1) << 5); R = (st >> 1) * 16 + swz / 64; C = (st & 1) * 32 + (swz % 64) / 2; }
__host__ __device__ __forceinline__ int perm32(int rho) { const int n = rho >> 4, i = rho & 15; return 8 * (i >> 2) + 4 * n + (i & 3); }
struct Unit { int pm, pn; };
struct Gemm { const bf16_t* A; const bf16_t* Bt; int M, N, K; };
struct StaticOrder {
    int nM, nN, nwg, G, c;
    __host__ __device__ void init(int M_, int N_, int G_, int c_) { nM = M_ / BM; nN = N_ / BM; nwg = nM * nN; G = G_; c = c_; }
    __host__ __device__ bool next(int i, Unit& u) const {
        const long L = (long)i * G + c; if (L >= nwg) return false;
        int wgid = (int)L; { const int q = nwg / NXCD, r = nwg % NXCD, xcd = wgid % NXCD, off = wgid / NXCD; wgid = (xcd < r ? xcd * (q + 1) : r * (q + 1) + (xcd - r) * q) + off; }
        const int nig = WGM * nN, gid = wgid / nig, fm = gid * WGM, gsz = (nM - fm) < WGM ? (nM - fm) : WGM;
        u.pm = fm + ((wgid % nig) % gsz); u.pn = (wgid % nig) / gsz; return true;
    }
};
struct EpiBf16 {
    static constexpr bool PERM = true;
    bf16_t* O; int ldc;
    __device__ __forceinline__ void operator()(const f32x4 (&acc)[2][2][4][2], const Unit& u, int wr, int wc, int fr, int fq) const {
        const int row0 = u.pm * BM + wr * 64 + fr; const int col0 = u.pn * BM + wc * 32 + 8 * fq;
#pragma unroll
        for (int ai = 0; ai < 2; ++ai)
#pragma unroll
            for (int m = 0; m < 4; ++m) { bf16_t* rowp = O + (size_t)(row0 + ai * HALF + m * 16) * ldc + col0;
#pragma unroll
                for (int bj = 0; bj < 2; ++bj) { const f32x4 v0 = acc[ai][bj][m][0], v1 = acc[ai][bj][m][1];
                    u32x4 w; w.x = cvtpk(v0[0], v0[1]); w.y = cvtpk(v0[2], v0[3]); w.z = cvtpk(v1[0], v1[1]); w.w = cvtpk(v1[2], v1[3]);
                    *(u32x4*)(rowp + bj * HALF) = w; } }
    }
};
__device__ __forceinline__ float silu_mul(float a, float u) { return a * u * __builtin_amdgcn_rcpf(1.0f + __builtin_amdgcn_exp2f(-a * LOG2E)); }
struct EpiSwiGLU {
    static constexpr bool PERM = true;
    bf16_t* O; int ldc;
    __device__ __forceinline__ void operator()(const f32x4 (&acc)[2][2][4][2], const Unit& u, int wr, int wc, int fr, int fq) const {
        const int row0 = u.pm * BM + wr * 64 + fr; const int col0 = u.pn * HALF + wc * 32 + 8 * fq;
#pragma unroll
        for (int ai = 0; ai < 2; ++ai)
#pragma unroll
            for (int m = 0; m < 4; ++m) { bf16_t* rowp = O + (size_t)(row0 + ai * HALF + m * 16) * ldc + col0;
                const f32x4 a0 = acc[ai][0][m][0], a1 = acc[ai][0][m][1], u0 = acc[ai][1][m][0], u1 = acc[ai][1][m][1];
                u32x4 w; w.x = cvtpk(silu_mul(a0[0], u0[0]), silu_mul(a0[1], u0[1])); w.y = cvtpk(silu_mul(a0[2], u0[2]), silu_mul(a0[3], u0[3]));
                w.z = cvtpk(silu_mul(a1[0], u1[0]), silu_mul(a1[1], u1[1])); w.w = cvtpk(silu_mul(a1[2], u1[2]), silu_mul(a1[3], u1[3]));
                *(u32x4*)rowp = w; }
    }
};
struct EpiResid {
    static constexpr bool PERM = false;
    const float* res; float* out; float alpha, s;
    __device__ __forceinline__ void operator()(const f32x4 (&acc)[2][2][4][2], const Unit& u, int wr, int wc, int fr, int fq) const {
        const int row0 = u.pm * BM + wr * 64 + fr; const int col0 = u.pn * BM + wc * 32 + 4 * fq;
#pragma unroll
        for (int ai = 0; ai < 2; ++ai)
#pragma unroll
            for (int m = 0; m < 4; ++m) { const size_t off = (size_t)(row0 + ai * HALF + m * 16) * D + col0;
#pragma unroll
                for (int bj = 0; bj < 2; ++bj)
#pragma unroll
                    for (int n = 0; n < 2; ++n) { const size_t o = off + bj * HALF + n * 16; const f32x4 rv = *(const f32x4*)(res + o); *(f32x4*)(out + o) = rv * alpha + acc[ai][bj][m][n] * s; } }
    }
};

template <class Epi>
__device__ __forceinline__ void gemm_phase(LAS unsigned char* lds, const Gemm g, const StaticOrder& S, const Epi& E) {
    const int tid = threadIdx.x, wid = __builtin_amdgcn_readfirstlane(tid >> 6), lane = tid & 63, wr = wid >> 2, wc = wid & 3, fr = lane & 15, fq = lane >> 4;
    const int K = g.K, nt = K / BK;
    unsigned voffA[2], voffB[2];
#pragma unroll
    for (int i = 0; i < 2; ++i) { int R, C; stage_rc(tid * 16 + i * 8192, R, C); const int Rb = Epi::PERM ? ((R & ~31) + perm32(R & 31)) : R;
        voffA[i] = (unsigned)(R * K + C) * 2u; voffB[i] = (unsigned)(Rb * K + C) * 2u; }
    const size_t kstep = (size_t)(BK * 2);
    const size_t hstep = (size_t)HALF * K * 2;
    const size_t tstep = 2 * hstep;
    const unsigned ldsw = (unsigned)wid * 1024u;
    const int aoff = lds_byte(wr * 64 + fr, fq * 8), boff = lds_byte(wc * 32 + fr, fq * 8);
#define PG8_SA(b, h) (((b) * 2 + (h)) * HTB)
#define PG8_SB(b, h) ((4 + (b) * 2 + (h)) * HTB)
#define PG8_STAGE(bufoff, gbase, voff) do { _Pragma("unroll") for (int _i = 0; _i < 2; ++_i) \
        __builtin_amdgcn_global_load_lds((const unsigned*)((const char*)(gbase) + (voff)[_i]), (LAS unsigned*)(lds + (bufoff) + ldsw + _i * 8192), 16, 0, 0); } while (0)
#define PG8_LDA(dst, b, h) do { _Pragma("unroll") for (int m = 0; m < 4; ++m) _Pragma("unroll") for (int k = 0; k < 2; ++k) dst[m][k] = *(const LAS bf16x8*)(lds + PG8_SA(b, h) + aoff + m * 2048 + k * 1024); } while (0)
#define PG8_LDB(dst, b, h) do { _Pragma("unroll") for (int n = 0; n < 2; ++n) _Pragma("unroll") for (int k = 0; k < 2; ++k) dst[n][k] = *(const LAS bf16x8*)(lds + PG8_SB(b, h) + boff + n * 2048 + k * 1024); } while (0)
#define PG8_MMA(ai, bj, At, Bt) do { __builtin_amdgcn_s_setprio(1); _Pragma("unroll") for (int m = 0; m < 4; ++m) _Pragma("unroll") for (int n = 0; n < 2; ++n) _Pragma("unroll") for (int k = 0; k < 2; ++k) \
        acc[ai][bj][m][n] = __builtin_amdgcn_mfma_f32_16x16x32_bf16(Bt[n][k], At[m][k], acc[ai][bj][m][n], 0, 0, 0); __builtin_amdgcn_s_setprio(0); } while (0)
#define PG8_WAIT_V(n) asm volatile("s_waitcnt vmcnt(" #n ")" ::: "memory")
#define PG8_WAIT_L(n) asm volatile("s_waitcnt lgkmcnt(" #n ")" ::: "memory")
#define PG8_BAR __builtin_amdgcn_s_barrier()
#define PG8_SCHED __builtin_amdgcn_sched_barrier(0)
    Unit cur, nxt; int ui = 0;
    if (!S.next(0, cur)) return;
    f32x4 acc[2][2][4][2];
#pragma unroll
    for (int a = 0; a < 2; ++a)
#pragma unroll
        for (int b = 0; b < 2; ++b)
#pragma unroll
            for (int m = 0; m < 4; ++m)
#pragma unroll
                for (int n = 0; n < 2; ++n) acc[a][b][m][n] = (f32x4){0.f, 0.f, 0.f, 0.f};
    bf16x8 At[4][2], B0[2][2], B1[2][2];
    const char* cA = (const char*)g.A + (size_t)cur.pm * tstep; const char* cB = (const char*)g.Bt + (size_t)cur.pn * tstep;
    PG8_STAGE(PG8_SB(0, 0), cB, voffB); PG8_STAGE(PG8_SB(0, 1), cB + hstep, voffB); PG8_STAGE(PG8_SA(0, 0), cA, voffA); PG8_STAGE(PG8_SA(0, 1), cA + hstep, voffA);
    if (wr == 1) PG8_BAR;
    PG8_WAIT_V(2); PG8_BAR;
    PG8_STAGE(PG8_SB(1, 0), cB + kstep, voffB); PG8_STAGE(PG8_SA(1, 0), cA + kstep, voffA); PG8_STAGE(PG8_SB(1, 1), cB + hstep + kstep, voffB);
    PG8_WAIT_V(6); PG8_BAR;
    for (;;) {
        const bool has_next = S.next(ui + 1, nxt);
        const char* nA = has_next ? (const char*)g.A + (size_t)nxt.pm * tstep : cA; const char* nB = has_next ? (const char*)g.Bt + (size_t)nxt.pn * tstep : cB;
        for (int t = 0; t < nt; t += 2) {
            const bool last = (t == nt - 2);
            const char* a1 = cA + (size_t)(t + 1) * kstep;
            const char* a2 = last ? nA : cA + (size_t)(t + 2) * kstep; const char* b2 = last ? nB : cB + (size_t)(t + 2) * kstep;
            const char* a3 = a2 + kstep; const char* b3 = b2 + kstep;
            PG8_LDB(B0, 0, 0); PG8_LDB(B1, 0, 1); PG8_SCHED; PG8_LDA(At, 0, 0); PG8_STAGE(PG8_SA(1, 1), a1 + hstep, voffA);
            PG8_WAIT_V(8); PG8_WAIT_L(0); PG8_BAR; PG8_MMA(0, 0, At, B0); PG8_MMA(0, 1, At, B1); PG8_BAR; PG8_SCHED;
            PG8_LDA(At, 0, 1); PG8_STAGE(PG8_SB(0, 0), b2, voffB); PG8_STAGE(PG8_SB(0, 1), b2 + hstep, voffB); PG8_STAGE(PG8_SA(0, 0), a2, voffA);
            PG8_WAIT_V(8); PG8_WAIT_L(0); PG8_BAR; PG8_MMA(1, 0, At, B0); PG8_MMA(1, 1, At, B1); PG8_BAR; PG8_SCHED;
            PG8_LDB(B0, 1, 0); PG8_LDB(B1, 1, 1); PG8_SCHED; PG8_LDA(At, 1, 0); PG8_STAGE(PG8_SA(0, 1), a2 + hstep, voffA);
            PG8_WAIT_V(8); PG8_WAIT_L(0); PG8_BAR; PG8_MMA(0, 0, At, B0); PG8_MMA(0, 1, At, B1); PG8_BAR; PG8_SCHED;
            PG8_LDA(At, 1, 1); PG8_STAGE(PG8_SB(1, 0), b3, voffB); PG8_STAGE(PG8_SB(1, 1), b3 + hstep, voffB); PG8_STAGE(PG8_SA(1, 0), a3, voffA);
            PG8_WAIT_V(8); PG8_WAIT_L(0); PG8_BAR; PG8_MMA(1, 0, At, B0); PG8_MMA(1, 1, At, B1); PG8_BAR; PG8_SCHED;
        }
        if (wr == 0) PG8_BAR;
        E(acc, cur, wr, wc, fr, fq);
        if (!has_next) break;
#pragma unroll
        for (int a = 0; a < 2; ++a)
#pragma unroll
            for (int b = 0; b < 2; ++b)
#pragma unroll
                for (int m = 0; m < 4; ++m)
#pragma unroll
                    for (int n = 0; n < 2; ++n) acc[a][b][m][n] = (f32x4){0.f, 0.f, 0.f, 0.f};
        cur = nxt; cA = nA; cB = nB; ++ui;
        if (wr == 1) PG8_BAR;
    }
    PG8_WAIT_V(0);
    PG8_BAR;
#undef PG8_SA
#undef PG8_SB
#undef PG8_STAGE
#undef PG8_LDA
#undef PG8_LDB
#undef PG8_MMA
#undef PG8_WAIT_V
#undef PG8_WAIT_L
#undef PG8_BAR
#undef PG8_SCHED
}
}

struct Args {
    const float* in[24];
    float* out;
    unsigned char* ws;
    int ph_lo, ph_hi;
};

#define SYNC() __syncthreads()

__device__ __forceinline__ void transpose_item(const float* W, int K, int ldw, int src_n0, bf16_t* WT, int dst_n0, int k0, float scale, LAS float* scr, int lane) {
#pragma unroll 8
    for (int i = 0; i < 32; ++i) { const int kk = 2 * i + (lane >> 5); scr[kk * 33 + (lane & 31)] = W[(size_t)(k0 + kk) * ldw + src_n0 + (lane & 31)]; }
    asm volatile("s_waitcnt lgkmcnt(0)" ::: "memory");
    const int c = lane & 7;
#pragma unroll
    for (int j = 0; j < 4; ++j) { const int n = (lane >> 3) + 8 * j; const LAS float* s = scr + (8 * c) * 33 + n;
        u32x4 o; o.x = cvtpk(s[0 * 33] * scale, s[1 * 33] * scale); o.y = cvtpk(s[2 * 33] * scale, s[3 * 33] * scale); o.z = cvtpk(s[4 * 33] * scale, s[5 * 33] * scale); o.w = cvtpk(s[6 * 33] * scale, s[7 * 33] * scale);
        *(u32x4*)(WT + (size_t)(dst_n0 + n) * K + k0 + 8 * c) = o; }
    asm volatile("s_waitcnt lgkmcnt(0)" ::: "memory");
}
__device__ __forceinline__ int up_src_col(int n0) { const int pn = n0 >> 8, j = n0 & 255; return (j < 128) ? pn * 128 + j : FF + pn * 128 + (j - 128); }

__device__ __forceinline__ void p0_prologue(const Args& a, LAS unsigned char* lds) {
    const int tid = threadIdx.x, lane = tid & 63, wid = tid >> 6;
    LAS float* scr = (LAS float*)(lds + wid * 16384);
    const int gw = blockIdx.x * 8 + wid, NGW = gridDim.x * 8;
    unsigned char* ws = a.ws;
    constexpr int I_UP = 16 * (NUP / 32), I_DN = (FF / 64) * (D / 32), I_IN = 16 * (NIN / 32), I_OUT = 16 * 32;
    constexpr int NITEMS = 2 * I_UP + 2 * I_DN + I_IN + I_OUT;
    for (int it = gw; it < NITEMS; it += NGW) {
        int r = it;
        if (r < 2 * I_UP) { const int which = r / I_UP; r -= which * I_UP; const int nblk = NUP / 32, kb = r / nblk, nb = r % nblk;
            transpose_item(a.in[which ? 19 : 3], D, NUP, up_src_col(32 * nb), (bf16_t*)(ws + (which ? WS_WUP2 : WS_WUP1)), 32 * nb, 64 * kb, 1.f, scr, lane); continue; }
        r -= 2 * I_UP;
        if (r < 2 * I_DN) { const int which = r / I_DN; r -= which * I_DN; const int nblk = D / 32, kb = r / nblk, nb = r % nblk;
            transpose_item(a.in[which ? 20 : 4], FF, D, 32 * nb, (bf16_t*)(ws + (which ? WS_WD2 : WS_WD1)), 32 * nb, 64 * kb, 1.f, scr, lane); continue; }
        r -= 2 * I_DN;
        if (r < I_IN) { const int nblk = NIN / 32, kb = r / nblk, nb = r % nblk;
            transpose_item(a.in[5], D, INC, 32 * nb, (bf16_t*)(ws + WS_WIN), 32 * nb, 64 * kb, (32 * nb < 512) ? QSCALE : 1.f, scr, lane); continue; }
        r -= I_IN;
        { const int nblk = D / 32, kb = r / nblk, nb = r % nblk;
            transpose_item(a.in[16], D, D, 32 * nb, (bf16_t*)(ws + WS_WOUT), 32 * nb, 64 * kb, 1.f, scr, lane); }
    }
    { float* wg = (float*)(ws + WS_WG); const float* win = a.in[5];
      for (int i = blockIdx.x * 512 + tid; i < 8 * D; i += gridDim.x * 512) { const int j = i >> 10, k = i & 1023; wg[i] = win[(size_t)k * INC + NIN + j]; } }
    { const f32x4* x4 = (const f32x4*)a.in[0]; u32x4* xb = (u32x4*)(ws + WS_XB);
      const size_t n8 = (size_t)M * D / 8;
      const size_t stride = (size_t)gridDim.x * 512;
      for (size_t i = (size_t)blockIdx.x * 512 + tid; i < n8; i += 4 * stride) { f32x4 v[4][2];
#pragma unroll
          for (int k = 0; k < 4; ++k) { const size_t ii = i + k * stride; if (ii < n8) { v[k][0] = x4[2 * ii]; v[k][1] = x4[2 * ii + 1]; } }
#pragma unroll
          for (int k = 0; k < 4; ++k) { const size_t ii = i + k * stride; if (ii < n8) { u32x4 o; o.x = cvtpk(v[k][0][0], v[k][0][1]); o.y = cvtpk(v[k][0][2], v[k][0][3]); o.z = cvtpk(v[k][1][0], v[k][1][1]); o.w = cvtpk(v[k][1][2], v[k][1][3]); xb[ii] = o; } } } }
}

template <bool WRITE_BF16, bool GATES>
__device__ __forceinline__ void ln_phase(const Args& a, LAS unsigned char* lds, float* hbuf, const float* g, const float* b) {
    const int tid = threadIdx.x, lane = tid & 63, wid = tid >> 6;
    LAS float* wgs = (LAS float*)lds;
    if (GATES) { const float* wg = (const float*)(a.ws + WS_WG); for (int i = tid; i < 8 * D; i += 512) wgs[i] = wg[i]; SYNC(); }
    f32x4 gv[4], bv[4];
#pragma unroll
    for (int j = 0; j < 4; ++j) { gv[j] = *(const f32x4*)(g + 4 * lane + 256 * j); bv[j] = *(const f32x4*)(b + 4 * lane + 256 * j); }
    bf16_t* xb = (bf16_t*)(a.ws + WS_XB); float* gate = (float*)(a.ws + WS_GATE);
    const int gw = blockIdx.x * 8 + wid, NGW = gridDim.x * 8;
    for (int m0 = 2 * gw; m0 < M; m0 += 2 * NGW) {
        f32x4 vv[2][4];
#pragma unroll
        for (int rr = 0; rr < 2; ++rr) { const f32x4* xr = (const f32x4*)(hbuf + (size_t)(m0 + rr) * D) + lane;
#pragma unroll
            for (int j = 0; j < 4; ++j) vv[rr][j] = xr[64 * j]; }
#pragma unroll
        for (int rr = 0; rr < 2; ++rr) {
            const int m = m0 + rr;
            f32x4* xr = (f32x4*)(hbuf + (size_t)m * D) + lane;
            f32x4 v[4]; float s = 0.f;
#pragma unroll
            for (int j = 0; j < 4; ++j) { v[j] = vv[rr][j]; s += (v[j][0] + v[j][1]) + (v[j][2] + v[j][3]); }
            const float mean = wave_sum(s) * (1.f / D); float s2 = 0.f;
#pragma unroll
            for (int j = 0; j < 4; ++j) { v[j] = v[j] - mean; s2 += (v[j][0] * v[j][0] + v[j][1] * v[j][1]) + (v[j][2] * v[j][2] + v[j][3] * v[j][3]); }
            const float rstd = 1.f / sqrtf(wave_sum(s2) * (1.f / D) + LN_EPS);
#pragma unroll
            for (int j = 0; j < 4; ++j) { v[j] = v[j] * rstd * gv[j] + bv[j]; xr[64 * j] = v[j]; }
            if (WRITE_BF16) { u32x2* o8 = (u32x2*)(xb + (size_t)m * D) + lane;
#pragma unroll
                for (int j = 0; j < 4; ++j) { u32x2 o; o.x = cvtpk(v[j][0], v[j][1]); o.y = cvtpk(v[j][2], v[j][3]); o8[64 * j] = o; } }
            if (GATES) {
                float p[8];
#pragma unroll
                for (int q = 0; q < 8; ++q) { float acc = 0.f;
#pragma unroll
                    for (int j = 0; j < 4; ++j) { const f32x4 w = *(const LAS f32x4*)(wgs + q * D + 4 * lane + 256 * j); acc += (v[j][0] * w[0] + v[j][1] * w[1]) + (v[j][2] * w[2] + v[j][3] * w[3]); }
                    p[q] = wave_sum(acc); }
                if (lane < 8) { float val = p[0];
#pragma unroll
                    for (int q = 1; q < 8; ++q) val = (lane == q) ? p[q] : val;
                    const float bias = (lane < 4) ? a.in[8][lane] : a.in[9][lane - 4];
                    gate[(size_t)m * 8 + lane] = val + bias; }
            }
        }
    }
    if (GATES) SYNC();
}

__device__ __forceinline__ void ml_pre_unit(const Args& a, LAS unsigned char* lds, int unit) {
    const int tid = threadIdx.x, lane = tid & 63, wid = tid >> 6, l32 = lane & 31, hi = lane >> 5;
    const int bh = unit >> 8, c = unit & 255, b = bh >> 2, h = bh & 3;
    const size_t row0 = (size_t)b * SEQ + c * 64;
    LAS bf16_t* Kt = (LAS bf16_t*)lds;
    LAS bf16_t* Vw = (LAS bf16_t*)(lds + 18432);
    LAS float* wl = (LAS float*)(lds + 36864);
    unsigned char* ws = a.ws;
    const bf16_t* proj = (const bf16_t*)(ws + WS_BIG);
    float* scal = (float*)(ws + WS_SCAL);
    if (wid == 0) {
        const float* gp = (const float*)(ws + WS_GATE) + (row0 + lane) * 8;
        const float ii = gp[h], fi = gp[4 + h];
        const float lf = fminf(fi, 0.f) - log1pf(expf(-fabsf(fi)));
        float bc = lf;
#pragma unroll
        for (int o = 1; o < 64; o <<= 1) { const float t = __shfl_up(bc, o); if (lane >= o) bc += t; }
        const float blast = __shfl(bc, 63);
        const float gg = blast - bc + ii;
        const float mloc = wave_max(gg);
        wl[lane] = expf(gg - mloc);
        scal[6144 + (size_t)bh * SEQ + c * 64 + lane] = bc;
        if (lane == 0) { scal[unit] = blast; scal[2048 + unit] = mloc; }
    }
    const float* cw = a.in[6]; const float* cb = a.in[7];
    u32x4 cu[4][4];
#pragma unroll
    for (int it = 0; it < 4; ++it) {
        const int which = it >> 1, l = (tid >> 4) + 32 * (it & 1), dg = tid & 15;
        const int ch = which * 512 + h * 128 + 8 * dg;
#pragma unroll
        for (int j = 0; j < 4; ++j) { const int sl = c * 64 + l - 3 + j;
            cu[it][j] = (sl >= 0) ? *(const u32x4*)(proj + ((size_t)b * SEQ + sl) * NIN + 1536 + ch) : (u32x4){0u, 0u, 0u, 0u}; }
    }
    u32x4 vu[2];
#pragma unroll
    for (int it = 0; it < 2; ++it) { const int l = (tid >> 4) + 32 * it, dg = tid & 15; vu[it] = *(const u32x4*)(proj + (row0 + l) * NIN + 2560 + h * 128 + 8 * dg); }
#pragma unroll
    for (int it = 0; it < 4; ++it) {
        const int which = it >> 1, l = (tid >> 4) + 32 * (it & 1), dg = tid & 15;
        const int ch = which * 512 + h * 128 + 8 * dg;
        float o[8];
#pragma unroll
        for (int e = 0; e < 8; ++e) o[e] = cb[ch + e];
#pragma unroll
        for (int j = 0; j < 4; ++j) { const u32x4 u = cu[it][j];
            const f32x4 w0 = *(const f32x4*)(cw + j * 1024 + ch), w1 = *(const f32x4*)(cw + j * 1024 + ch + 4);
            o[0] += __uint_as_float(u.x << 16) * w0[0]; o[1] += __uint_as_float(u.x & 0xffff0000u) * w0[1];
            o[2] += __uint_as_float(u.y << 16) * w0[2]; o[3] += __uint_as_float(u.y & 0xffff0000u) * w0[3];
            o[4] += __uint_as_float(u.z << 16) * w1[0]; o[5] += __uint_as_float(u.z & 0xffff0000u) * w1[1];
            o[6] += __uint_as_float(u.w << 16) * w1[2]; o[7] += __uint_as_float(u.w & 0xffff0000u) * w1[3]; }
        const float sc = which ? KSCALE : 1.f;
#pragma unroll
        for (int e = 0; e < 8; ++e) o[e] = o[e] * fsigmoid(o[e]) * sc;
        u32x4 w; w.x = cvtpk(o[0], o[1]); w.y = cvtpk(o[2], o[3]); w.z = cvtpk(o[4], o[5]); w.w = cvtpk(o[6], o[7]);
        bf16_t* dst = (bf16_t*)(ws + (which ? WS_MK : WS_MQ)) + (row0 + l) * 512 + h * 128 + 8 * dg;
        *(u32x4*)dst = w;
        if (which) {
#pragma unroll
            for (int e = 0; e < 8; ++e) Kt[(8 * dg + e) * 72 + l] = f2bf(o[e]);
        }
    }
    SYNC();
#pragma unroll
    for (int it = 0; it < 2; ++it) {
        const int l = (tid >> 4) + 32 * it, dg = tid & 15;
        const u32x4 u = vu[it];
        const float w = wl[l];
        float v[8] = {__uint_as_float(u.x << 16), __uint_as_float(u.x & 0xffff0000u), __uint_as_float(u.y << 16), __uint_as_float(u.y & 0xffff0000u),
                      __uint_as_float(u.z << 16), __uint_as_float(u.z & 0xffff0000u), __uint_as_float(u.w << 16), __uint_as_float(u.w & 0xffff0000u)};
#pragma unroll
        for (int e = 0; e < 8; ++e) Vw[(8 * dg + e) * 72 + l] = f2bf(v[e] * w);
    }
    SYNC();
    {
        const int vb = wid >> 1, kb0 = 2 * (wid & 1);
        bf16_t* kv = (bf16_t*)(ws + WS_KV) + (size_t)unit * 16384;
#pragma unroll
        for (int kk = 0; kk < 2; ++kk) { const int kb = kb0 + kk; f32x16 acc = {};
#pragma unroll
            for (int ks = 0; ks < 4; ++ks) { const bf16x8 A = *(const LAS bf16x8*)(Vw + (32 * vb + l32) * 72 + 16 * ks + 8 * hi); const bf16x8 B = *(const LAS bf16x8*)(Kt + (32 * kb + l32) * 72 + 16 * ks + 8 * hi);
                acc = MFMA32(A, B, acc); }
#pragma unroll
            for (int r = 0; r < 16; ++r) kv[(32 * vb + crow(r, hi)) * 128 + 32 * kb + l32] = f2bf(acc[r]); }
    }
    if (tid < 128) { float s = 0.f;
#pragma unroll 8
        for (int l = 0; l < 64; ++l) s += wl[l] * bf2f(Kt[tid * 72 + l]);
        ((float*)(ws + WS_NLOC))[(size_t)unit * 128 + tid] = s; }
    SYNC();
}
__device__ __forceinline__ void vt_unit(const Args& a, LAS unsigned char* lds, int tv) {
    const int tid = threadIdx.x;
    LAS bf16_t* T = (LAS bf16_t*)lds;
    const bf16_t* proj = (const bf16_t*)(a.ws + WS_BIG);
    const size_t r0 = (size_t)tv * 64; const int b = tv >> 8, s0 = (tv & 255) * 64;
#pragma unroll
    for (int i = 0; i < 8; ++i) { const int id = tid + 512 * i, row = id >> 6, ch = id & 63;
        *(LAS u32x4*)(T + row * 520 + 8 * ch) = *(const u32x4*)(proj + (r0 + row) * NIN + 1024 + 8 * ch); }
    SYNC();
    { const int h = tid >> 7, d = tid & 127;
      bf16_t* dst = (bf16_t*)(a.ws + WS_VT) + ((size_t)(b * 4 + h) * 128 + d) * VSTR + s0;
#pragma unroll
      for (int i = 0; i < 8; ++i) { unsigned w[4];
#pragma unroll
          for (int e = 0; e < 4; ++e) { const int k0 = 16 * (i >> 1) + 4 * (i & 1) + ((2 * e) & 3) + 8 * (e >> 1);
              w[e] = (unsigned)T[k0 * 520 + tid] | ((unsigned)T[(k0 + 1) * 520 + tid] << 16); }
          *(u32x4*)(dst + 8 * i) = (u32x4){w[0], w[1], w[2], w[3]}; } }
    SYNC();
}

__device__ __forceinline__ void ml_scan(const Args& a) {
    const int tid = threadIdx.x;
    unsigned char* ws = a.ws;
    const float* scal = (const float*)(ws + WS_SCAL);
    for (int g = blockIdx.x; g < 130; g += gridDim.x) {
        if (g < 128) {
            const int gid = g * 512 + tid, bh = gid >> 13, w = gid & 8191;
            unsigned* p = (unsigned*)(ws + WS_KV) + (size_t)bh * 256 * 8192 + w;
            float C0 = 0.f, C1 = 0.f, m = 0.f;
            for (int c0 = 0; c0 < 256; c0 += 8) {
                unsigned kv[8];
#pragma unroll
                for (int i = 0; i < 8; ++i) kv[i] = p[(size_t)(c0 + i) * 8192];
#pragma unroll
                for (int i = 0; i < 8; ++i) {
                    const float bl = scal[bh * 256 + c0 + i], ml = scal[2048 + bh * 256 + c0 + i];
                    const float mn = fmaxf(bl + m, ml), dec = expf(bl + m - mn), sc = expf(ml - mn);
                    p[(size_t)(c0 + i) * 8192] = cvtpk(C0, C1);
                    C0 = dec * C0 + sc * __uint_as_float(kv[i] << 16); C1 = dec * C1 + sc * __uint_as_float(kv[i] & 0xffff0000u); m = mn;
                }
            }
        } else {
            const int gid = (g - 128) * 512 + tid, bh = gid >> 7, k = gid & 127;
            float* p = (float*)(ws + WS_NLOC) + (size_t)bh * 256 * 128 + k;
            float* mprev = (float*)(ws + WS_SCAL) + 4096;
            float n = 0.f, m = 0.f;
            for (int c = 0; c < 256; ++c) {
                const float bl = scal[bh * 256 + c], ml = scal[2048 + bh * 256 + c];
                const float mn = fmaxf(bl + m, ml), dec = expf(bl + m - mn), sc = expf(ml - mn);
                const float nl = p[c * 128];
                p[c * 128] = n; if (k == 0) mprev[bh * 256 + c] = m;
                n = dec * n + sc * nl; m = mn;
            }
        }
    }
}

__device__ __forceinline__ void ml_out_phase(const Args& a, LAS unsigned char* lds) {
    const int tid = threadIdx.x, lane = tid & 63, wid = tid >> 6, l32 = lane & 31, hi = lane >> 5;
    unsigned char* ws = a.ws;
    LAS bf16_t* Qs = (LAS bf16_t*)lds;
    LAS bf16_t* Ks = (LAS bf16_t*)(lds + 17408);
    LAS bf16_t* Vt = (LAS bf16_t*)(lds + 34816);
    LAS bf16_t* Cs = (LAS bf16_t*)(lds + 53248);
    LAS float* Hs = (LAS float*)(lds + 88064);
    LAS float* bs = (LAS float*)(lds + 121856);
    LAS float* lis = bs + 64;
    LAS float* ns = bs + 128;
    LAS float* wsf = bs + 256 + wid * 64;
    const bf16_t* proj = (const bf16_t*)(ws + WS_BIG);
    const float* scal = (const float*)(ws + WS_SCAL);
    const int G = gridDim.x;
    int unit = blockIdx.x;
    if (unit >= 2048) return;
    u32x4 rq[2], rk[2], rv[2], rc[4]; float rs0 = 0.f, rs1 = 0.f, rmp;
#define MLO_LOAD(UU) do { const int _bh = (UU) >> 8, _c = (UU) & 255, _b = _bh >> 2, _h = _bh & 3; const size_t _r0 = (size_t)_b * SEQ + _c * 64; \
        _Pragma("unroll") for (int i = 0; i < 2; ++i) { const int id = tid + 512 * i, row = id >> 4, ch = id & 15; \
            rq[i] = *(const u32x4*)((const bf16_t*)(ws + WS_MQ) + (_r0 + row) * 512 + _h * 128 + 8 * ch); \
            rk[i] = *(const u32x4*)((const bf16_t*)(ws + WS_MK) + (_r0 + row) * 512 + _h * 128 + 8 * ch); \
            } \
        _Pragma("unroll") for (int i = 0; i < 4; ++i) { const int id = tid + 512 * i, row = id >> 4, ch = id & 15; \
            rc[i] = *(const u32x4*)((const bf16_t*)(ws + WS_KV) + (size_t)(UU) * 16384 + row * 128 + 8 * ch); } \
        if (tid < 64) { rs0 = scal[6144 + (size_t)_bh * SEQ + _c * 64 + tid]; rs1 = ((const float*)(ws + WS_GATE))[(_r0 + tid) * 8 + _h]; } \
        else if (tid < 192) { rs0 = ((const float*)(ws + WS_NLOC))[(size_t)(UU) * 128 + tid - 64]; } \
        rmp = scal[4096 + (UU)]; } while (0)
#define MLO_LOADV(UU) do { const int _bh = (UU) >> 8, _c = (UU) & 255, _b = _bh >> 2, _h = _bh & 3; const size_t _r0 = (size_t)_b * SEQ + _c * 64; \
        _Pragma("unroll") for (int i = 0; i < 2; ++i) { const int id = tid + 512 * i, row = id >> 4, ch = id & 15; rv[i] = *(const u32x4*)(proj + (_r0 + row) * NIN + 2560 + _h * 128 + 8 * ch); } } while (0)
    MLO_LOAD(unit); MLO_LOADV(unit);
    const float g0 = a.in[15][lane], g1 = a.in[15][lane + 64];
    for (; unit < 2048; unit += G) {
    int tq = threadIdx.x; asm volatile("" : "+v"(tq));
    const int tid = tq, lane = tid & 63, wid = tid >> 6, l32 = lane & 31, hi = lane >> 5;
    LAS float* wsf = bs + 256 + wid * 64;
    const int bh = unit >> 8, c = unit & 255, b = bh >> 2, h = bh & 3;
    const size_t row0 = (size_t)b * SEQ + c * 64;
#pragma unroll
    for (int i = 0; i < 4; ++i) { const int id = tid + 512 * i, row = id >> 4, ch = id & 15;
        *(LAS u32x4*)(Cs + row * 136 + 8 * ch) = rc[i]; }
#pragma unroll
    for (int i = 0; i < 2; ++i) { const int id = tid + 512 * i, row = id >> 4, ch = id & 15;
        *(LAS u32x4*)(Qs + row * 136 + 8 * ch) = rq[i];
        *(LAS u32x4*)(Ks + row * 136 + 8 * ch) = rk[i];
        const unsigned uu[4] = {rv[i].x, rv[i].y, rv[i].z, rv[i].w};
#pragma unroll
        for (int e = 0; e < 4; ++e) { Vt[(8 * ch + 2 * e) * 72 + row] = (bf16_t)(uu[e] & 0xffffu); Vt[(8 * ch + 2 * e + 1) * 72 + row] = (bf16_t)(uu[e] >> 16); } }
    if (tid < 64) { bs[tid] = rs0; lis[tid] = rs1; }
    else if (tid < 192) { ns[tid - 64] = rs0; }
    const float mprev = rmp;
    asm volatile("s_waitcnt lgkmcnt(0)" ::: "memory"); __builtin_amdgcn_s_barrier(); asm volatile("" ::: "memory");
    unsigned ogp[8];
#pragma unroll
    for (int i = 0; i < 8; ++i) { const bf16_t* op = proj + (row0 + 8 * wid + i) * NIN + 3072 + h * 128; ogp[i] = (unsigned)op[lane] | ((unsigned)op[lane + 64] << 16); }
    if (unit + G < 2048) MLO_LOAD(unit + G);
    const int jb = wid & 1, vb = wid >> 1, j = 32 * jb + l32;
    f32x16 st[2];
#pragma unroll
    for (int sb = 0; sb < 2; ++sb) { st[sb] = (f32x16){};
        if (sb <= jb) {
#pragma unroll
            for (int ks = 0; ks < 8; ++ks) { const bf16x8 A = *(const LAS bf16x8*)(Ks + (32 * sb + l32) * 136 + 16 * ks + 8 * hi); const bf16x8 B = *(const LAS bf16x8*)(Qs + (32 * jb + l32) * 136 + 16 * ks + 8 * hi);
                st[sb] = MFMA32(A, B, st[sb]); } } }
    __builtin_amdgcn_sched_barrier(0);
    __builtin_amdgcn_sched_barrier(0);
    const float bj = bs[j], m_inter = bj + mprev;
    float mx = -INFINITY;
#pragma unroll
    for (int sb = 0; sb < 2; ++sb)
#pragma unroll
        for (int r = 0; r < 16; ++r) { const int s = 32 * sb + crow(r, hi); const float dm = bj - bs[s] + lis[s]; mx = fmaxf(mx, (s <= j) ? dm : -INFINITY); }
    mx = fmaxf(mx, __shfl_xor(mx, 32));
    __builtin_amdgcn_sched_barrier(0);
    __builtin_amdgcn_sched_barrier(0);
    const float mj = fmaxf(m_inter, mx);
    float rowsum = 0.f; unsigned pk[2][8];
#pragma unroll
    for (int sb = 0; sb < 2; ++sb) { float sw[16];
#pragma unroll
        for (int r = 0; r < 16; ++r) { const int s = 32 * sb + crow(r, hi); const float ew = fexp(bj - bs[s] + lis[s] - mj); const float wgt = (s <= j) ? ew : 0.f; sw[r] = st[sb][r] * wgt; rowsum += sw[r]; }
#pragma unroll
        for (int e = 0; e < 8; ++e) pk[sb][e] = cvtpk(sw[2 * e], sw[2 * e + 1]);
        __builtin_amdgcn_sched_barrier(0); }
    rowsum += __shfl_xor(rowsum, 32);
    __builtin_amdgcn_sched_barrier(0);
    __builtin_amdgcn_sched_barrier(0);
    float nq = 0.f;
#pragma unroll
    for (int k8 = 0; k8 < 8; ++k8) { const u32x4 u = *(const LAS u32x4*)(Qs + j * 136 + 64 * hi + 8 * k8); const LAS float* np = ns + 64 * hi + 8 * k8;
        nq += __uint_as_float(u.x << 16) * np[0] + __uint_as_float(u.x & 0xffff0000u) * np[1] + __uint_as_float(u.y << 16) * np[2] + __uint_as_float(u.y & 0xffff0000u) * np[3]
            + __uint_as_float(u.z << 16) * np[4] + __uint_as_float(u.z & 0xffff0000u) * np[5] + __uint_as_float(u.w << 16) * np[6] + __uint_as_float(u.w & 0xffff0000u) * np[7]; }
    nq += __shfl_xor(nq, 32);
    __builtin_amdgcn_sched_barrier(0);
    __builtin_amdgcn_sched_barrier(0);
    const float inter_w = fexp(m_inter - mj);
    const float den = rowsum + inter_w * nq;
    const float dscale = 1.f / fmaxf(fabsf(den), fexp(-mj));
    if (hi == 0) { wsf[l32] = dscale; wsf[32 + l32] = inter_w * dscale; }
    asm volatile("s_waitcnt lgkmcnt(0)" ::: "memory");
    __builtin_amdgcn_sched_barrier(0);
    __builtin_amdgcn_sched_barrier(0);
    f32x16 a1 = {}, a2 = {};
#pragma unroll
    for (int sb = 0; sb < 2; ++sb)
        if (sb <= jb) {
#pragma unroll
            for (int jj = 0; jj < 2; ++jj) { const bf16x8 A = __builtin_bit_cast(bf16x8, (u32x4){pk[sb][4 * jj], pk[sb][4 * jj + 1], pk[sb][4 * jj + 2], pk[sb][4 * jj + 3]});
                const LAS bf16_t* vp = Vt + (32 * vb + l32) * 72 + 32 * sb + 16 * jj + 4 * hi;
                const u32x2 lo = *(const LAS u32x2*)vp, hi2 = *(const LAS u32x2*)(vp + 8);
                const bf16x8 B = __builtin_bit_cast(bf16x8, (u32x4){lo.x, lo.y, hi2.x, hi2.y});
                a1 = MFMA32(A, B, a1); } }
#pragma unroll
    for (int ks = 0; ks < 8; ++ks) { const bf16x8 A = *(const LAS bf16x8*)(Qs + (32 * jb + l32) * 136 + 16 * ks + 8 * hi); const bf16x8 B = *(const LAS bf16x8*)(Cs + (32 * vb + l32) * 136 + 16 * ks + 8 * hi);
        a2 = MFMA32(A, B, a2); }
#pragma unroll
    for (int r = 0; r < 16; ++r) { const int jr = crow(r, hi); Hs[(32 * jb + jr) * 132 + 32 * vb + l32] = a1[r] * wsf[jr] + a2[r] * wsf[32 + jr]; }
    asm volatile("s_waitcnt lgkmcnt(0)" ::: "memory"); __builtin_amdgcn_s_barrier(); asm volatile("" ::: "memory");
    if (unit + G < 2048) MLO_LOADV(unit + G);
    { bf16_t* mix = (bf16_t*)(ws + WS_XB);
#pragma unroll
      for (int i = 0; i < 8; ++i) { const int jr = 8 * wid + i; const float x0 = Hs[jr * 132 + lane], x1 = Hs[jr * 132 + lane + 64];
          const float mean = wave_sum(x0 + x1) * (1.f / 128.f); const float d0 = x0 - mean, d1 = x1 - mean;
          const float rstd = 1.f / sqrtf(wave_sum(d0 * d0 + d1 * d1) * (1.f / 128.f) + LN_EPS);
          const float o0 = __uint_as_float(ogp[i] << 16), o1 = __uint_as_float(ogp[i] & 0xffff0000u);
          bf16_t* mp = mix + (row0 + jr) * D + 512 + h * 128;
          mp[lane] = f2bf(d0 * rstd * g0 * fsigmoid(o0)); mp[lane + 64] = f2bf(d1 * rstd * g1 * fsigmoid(o1)); } }
    asm volatile("s_waitcnt lgkmcnt(0)" ::: "memory"); __builtin_amdgcn_s_barrier(); asm volatile("" ::: "memory");
    }
#undef MLO_LOAD
#undef MLO_LOADV
}

namespace att {
constexpr int SLOT = 32768, NSLOT = 4, OFF_TAB = NSLOT * SLOT, OFF_WSF = OFF_TAB + 1024, OFF_BC = OFF_WSF + 2048;
constexpr float THR = 12.f;
#define ATT_WAIT_V(n) asm volatile("s_waitcnt vmcnt(" #n ")" ::: "memory")
#define ATT_BAR() do { asm volatile("s_waitcnt lgkmcnt(0)" ::: "memory"); __builtin_amdgcn_s_barrier(); asm volatile("" ::: "memory"); } while (0)

__device__ __forceinline__ float max3f(float a, float b, float c) { float r; asm("v_max3_f32 %0, %1, %2, %3" : "=v"(r) : "v"(a), "v"(b), "v"(c)); return r; }
__device__ __forceinline__ float sm_pre(f32x16& s, bool near, LAS const float* tp, float ref, bool first, float& mhat, float& lsum, f32x16 (&o)[4], LAS float* wsf, int l32, int hi) {
    if (near) {
#pragma unroll
        for (int r = 0; r < 16; ++r) s[r] += tp[(r & 3) + 8 * (r >> 2)];
    }
    float rm = max3f(s[0], s[1], s[2]); float rm2 = max3f(s[3], s[4], s[5]);
    rm = max3f(rm, s[6], s[7]); rm2 = max3f(rm2, s[8], s[9]); rm = max3f(rm, s[10], s[11]); rm2 = max3f(rm2, s[12], s[13]); rm = max3f(rm, s[14], s[15]);
    rm = max3f(rm, rm2, rm2);
    { auto rr = __builtin_amdgcn_permlane32_swap(__float_as_uint(rm), __float_as_uint(rm), false, false); rm = max3f(__uint_as_float(rr[0]), __uint_as_float(rr[1]), rm); }
    rm += ref - mhat;
    if (first) asm volatile("s_nop 0");
    if (__any(rm > THR)) {
        const float dl = fmaxf(rm, 0.f);
        mhat += dl;
        {
            const float f = __builtin_amdgcn_exp2f(-dl);
            lsum *= f;
            if (hi == 0) wsf[l32] = f;
            asm volatile("s_waitcnt lgkmcnt(0)" ::: "memory");
#pragma unroll
            for (int r4 = 0; r4 < 4; ++r4) { const f32x4 fv = *(const LAS f32x4*)(wsf + 8 * r4 + 4 * hi);
#pragma unroll
                for (int d = 0; d < 4; ++d) { o[d][4 * r4] *= fv[0]; o[d][4 * r4 + 1] *= fv[1]; o[d][4 * r4 + 2] *= fv[2]; o[d][4 * r4 + 3] *= fv[3]; } }
            asm volatile("s_waitcnt lgkmcnt(0)" ::: "memory");
        }
    }
    return ref - mhat;
}
__device__ __forceinline__ float fadd_s(float a, float b) { float r; asm("v_add_f32_e32 %0, %1, %2" : "=v"(r) : "v"(a), "v"(b)); return r; }
__device__ __forceinline__ void sm_exp(f32x16& s, float nsub, float& lsum, unsigned (&pk)[8]) {
    if (__any(nsub != 0.f)) {
#pragma unroll
        for (int r = 0; r < 16; ++r) s[r] += nsub;
    }
    float p0 = 0.f, p1 = 0.f, p2 = 0.f, p3 = 0.f;
#pragma unroll
    for (int r = 0; r < 16; r += 4) { const float a = __builtin_amdgcn_exp2f(s[r]), b = __builtin_amdgcn_exp2f(s[r + 1]), c = __builtin_amdgcn_exp2f(s[r + 2]), d = __builtin_amdgcn_exp2f(s[r + 3]);
        p0 = fadd_s(p0, a); p1 = fadd_s(p1, b); p2 = fadd_s(p2, c); p3 = fadd_s(p3, d);
        pk[r / 2] = cvtpk(a, b); pk[r / 2 + 1] = cvtpk(c, d); }
    lsum = fadd_s(lsum, fadd_s(fadd_s(p0, p1), fadd_s(p2, p3)));
}

__device__ __forceinline__ void attn_unit(const Args& a, LAS unsigned char* lds, float lam, int bh, int qb) {
    const int tid = threadIdx.x, lane = tid & 63, wid = __builtin_amdgcn_readfirstlane(tid >> 6), l32 = lane & 31, hi = lane >> 5;
    const int mp = wid >> 2, rg = wid & 3;
    const int b = bh >> 2, h = bh & 3;
    unsigned char* ws = a.ws;
    const bf16_t* proj = (const bf16_t*)(ws + WS_BIG);
    const bf16_t* VtG = (const bf16_t*)(ws + WS_VT);
    LAS float* tab = (LAS float*)(lds + OFF_TAB);
    LAS float* wsf = (LAS float*)(lds + OFF_WSF) + wid * 64;
    const size_t rowb = (size_t)b * SEQ;
    ATT_WAIT_V(0);
    if (tid < 256) { const int rel = tid - 191; const int n = rel < 0 ? -rel : rel; int bucket;
        if (n < 8) bucket = n; else { int lg = 31 - __clz(n * n); bucket = 2 + lg; if (bucket > 15) bucket = 15; }
        if (rel > 0) bucket += 16;
        tab[tid] = (a.in[23][bucket * 4 + h] - a.in[23][15 * 4 + h]) * LOG2E; }
    const int kvr = tid >> 3, kc = (tid & 7) ^ ((kvr >> 1) & 7);
    const bf16_t* ksrc = proj + (rowb + kvr) * NIN + 512 + h * 128 + 8 * kc;
    const bf16_t* vsrc = VtG + ((size_t)bh * 128 + kvr) * VSTR + 8 * kc;
#define ATT_ISSUE(t, slot) do { LAS unsigned char* _d = lds + (slot) * SLOT + wid * 1024; const bf16_t* _k = ksrc + (size_t)(t) * 64 * NIN; const bf16_t* _v = vsrc + (t) * 64; \
        __builtin_amdgcn_global_load_lds((const unsigned*)_k, (LAS unsigned*)_d, 16, 0, 0); \
        __builtin_amdgcn_global_load_lds((const unsigned*)(_k + 64), (LAS unsigned*)(_d + 8192), 16, 0, 0); \
        __builtin_amdgcn_global_load_lds((const unsigned*)_v, (LAS unsigned*)(_d + 16384), 16, 0, 0); \
        __builtin_amdgcn_global_load_lds((const unsigned*)(_v + (size_t)64 * VSTR), (LAS unsigned*)(_d + 24576), 16, 0, 0); } while (0)
    const int qrow = 128 * qb + 32 * rg + l32;
    bf16x8 qf[4];
    { const bf16_t* qp = proj + (rowb + qrow) * NIN + h * 128 + 64 * mp + 8 * hi;
#pragma unroll
      for (int d0 = 0; d0 < 4; ++d0) qf[d0] = *(const bf16x8*)(qp + 16 * d0); }
    const int NT = 2 * qb + 2, cq = 2 * qb + (rg >> 1);
    ATT_ISSUE(0, 0); ATT_ISSUE(1, 1); if (NT > 2) ATT_ISSUE(2, 2);
    f32x16 o[4];
#pragma unroll
    for (int d = 0; d < 4; ++d) o[d] = (f32x16){};
    float mhat = 0.f, lsum = 0.f;
#define ATT_KLD(tt, blk, KN) do { \
        int _sw = ((l32 >> 1) & 7) << 4; asm volatile("" : "+v"(_sw)); const int _xo = _sw ^ (hi << 4); \
        LAS const unsigned char* _kb = lds + ((tt) & 3) * SLOT + mp * 8192 + (blk) * 4096 + l32 * 128; \
        _Pragma("unroll") for (int d0 = 0; d0 < 4; ++d0) KN[d0] = *(const LAS bf16x8*)(_kb + (_xo ^ (d0 << 5))); } while (0)
#define ATT_SMM(KN, S) do { S = MFMA32(KN[0], qf[0], ((f32x16){})); _Pragma("unroll") for (int d0 = 1; d0 < 4; ++d0) S = MFMA32(KN[d0], qf[d0], S); } while (0)
#define ATT_S1(tt, blk, S) do { bf16x8 _kk[4]; ATT_KLD(tt, blk, _kk); ATT_SMM(_kk, S); } while (0)
#define ATT_VLD(DST, c) do { _Pragma("unroll") for (int d = 0; d < 4; ++d) DST[d] = *(const LAS bf16x8*)(_vb + d * 4096 + (_xv ^ ((c) << 4))); } while (0)
#define ATT_PV1(PK, jj, VF) do { const bf16x8 _P = __builtin_bit_cast(bf16x8, (u32x4){PK[4 * (jj)], PK[4 * (jj) + 1], PK[4 * (jj) + 2], PK[4 * (jj) + 3]}); \
        _Pragma("unroll") for (int d = 0; d < 4; ++d) o[d] = MFMA32(_P, VF[d], o[d]); } while (0)
#define ATT_FENCE() __builtin_amdgcn_sched_barrier(0)
#ifndef ATT_NOSCHED
#define SCHED_A() do { _Pragma("unroll") for (int _i = 0; _i < 4; ++_i) { __builtin_amdgcn_sched_group_barrier(0x008, 1, 0); __builtin_amdgcn_sched_group_barrier(0x002, 12, 0); } } while (0)
#else
#define SCHED_A() do {} while (0)
#endif
    f32x16 sX, sY;
    if (NT > 2) ATT_WAIT_V(8); else ATT_WAIT_V(4);
    ATT_BAR();
    ATT_S1(0, 0, sX);
    for (int t = 0; t < NT; ++t) {
        if (t + 3 <= NT) ATT_WAIT_V(4); else ATT_WAIT_V(0);
        ATT_BAR();
        if (t + 3 < NT) ATT_ISSUE(t + 3, (t + 3) & 3);
        if (t <= cq) {
            const bool near = (t >= cq - 2);
            int _swv = ((l32 >> 1) & 7) << 4; asm volatile("" : "+v"(_swv)); const int _xv = _swv ^ (hi << 4);
            LAS const unsigned char* _vb = lds + (t & 3) * SLOT + 16384 + l32 * 128;
            int relb = 64 * t - qrow + 191 + 4 * hi; asm volatile("" : "+v"(relb));
            LAS const float* tp = tab + relb;
            bf16x8 va[4], vc[4]; unsigned pk[8];
            const float ref = 0.f;
            bf16x8 kn[4];
            ATT_VLD(va, 0); ATT_VLD(vc, 2); ATT_KLD(t, 1, kn);
            const float nsX = sm_pre(sX, near, tp, ref, t == 0, mhat, lsum, o, wsf, l32, hi);
            ATT_FENCE();
            ATT_SMM(kn, sY);
            sm_exp(sX, nsX, lsum, pk);
            SCHED_A();
            ATT_FENCE();
            ATT_PV1(pk, 0, va); ATT_PV1(pk, 1, vc);
            ATT_FENCE();
            ATT_VLD(va, 4); ATT_VLD(vc, 6); ATT_KLD(t + 1, 0, kn);
            const float nsY = sm_pre(sY, near, tp + 32, ref, false, mhat, lsum, o, wsf, l32, hi);
            ATT_FENCE();
            ATT_SMM(kn, sX);
            sm_exp(sY, nsY, lsum, pk);
            SCHED_A();
            ATT_FENCE();
            ATT_PV1(pk, 0, va); ATT_PV1(pk, 1, vc);
            ATT_FENCE();
        }
    }
    int opq = 0; asm volatile("" : "+v"(opq));
    lsum += __shfl_xor(lsum, 32);
    if (hi == 0) wsf[l32] = (mp ? lam : 1.f) / lsum;
    asm volatile("s_waitcnt lgkmcnt(0)" ::: "memory");
#pragma unroll
    for (int r = 0; r < 16; ++r) { const float f = wsf[crow(r, hi)];
#pragma unroll
        for (int d = 0; d < 4; ++d) o[d][r] *= f; }
    ATT_BAR();
    LAS float* xch = (LAS float*)lds + rg * 4096 + lane + opq;
    if (mp == 1) {
#pragma unroll
        for (int d = 0; d < 4; ++d)
#pragma unroll
            for (int r = 0; r < 16; ++r) xch[(d * 16 + r) * 64] = o[d][r];
    }
    ATT_BAR();
    if (mp == 0) {
        float ss[16];
#pragma unroll
        for (int r = 0; r < 16; ++r) { float acc = 0.f;
#pragma unroll
            for (int d = 0; d < 4; ++d) { const float v = o[d][r] - xch[(d * 16 + r) * 64]; o[d][r] = v; acc += v * v; }
            ss[r] = acc; }
#pragma unroll
        for (int r = 0; r < 16; ++r) {
            ss[r] = half32_sum(ss[r]);
            ss[r] = (1.f - LAMBDA_INIT) / sqrtf(ss[r] * (1.f / 128.f) + LN_EPS); }
        bf16_t* mix = (bf16_t*)(ws + WS_XB) + (rowb + 128 * qb + 32 * rg) * D + h * 128 + opq;
        float gd[4];
#pragma unroll
        for (int d = 0; d < 4; ++d) gd[d] = a.in[14][32 * d + l32 + opq];
#pragma unroll
        for (int r = 0; r < 16; ++r)
#pragma unroll
            for (int d = 0; d < 4; ++d) mix[(size_t)crow(r, hi) * D + 32 * d + l32] = f2bf(o[d][r] * ss[r] * gd[d]);
    }
    ATT_BAR();
}
}

#define XB_TMO      128
#define XB_XCNT(j)  (256  + 64 * (j))
#define XB_XSUB(j)  (1280 + 64 * (j))
#define XB_XGEN(j)  (2304 + 64 * (j))
#define XB_TOP      3328
#define XB_TOPGEN   3392
#define XCD_BAR_WORDS 3456
#define XB_SPIN_CAP (1u << 20)
__device__ __forceinline__ unsigned xb_ld(unsigned* p)              { return __hip_atomic_load(p, __ATOMIC_RELAXED, __HIP_MEMORY_SCOPE_AGENT); }
__device__ __forceinline__ unsigned xb_add(unsigned* p, unsigned v) { return __hip_atomic_fetch_add(p, v, __ATOMIC_RELAXED, __HIP_MEMORY_SCOPE_AGENT); }
__device__ __forceinline__ unsigned xb_xcc_id() { return (unsigned)__builtin_amdgcn_s_getreg((3 << 11) | 20) & 0xFu; }
#define XB_SPIN(cond, bar) do { unsigned _sp = 0; while (cond) { __builtin_amdgcn_s_sleep(1); \
    if ((++_sp & 255u) == 0u) { if (xb_ld(&(bar)[XB_TMO])) break; if (_sp > XB_SPIN_CAP) { atomicAdd(&(bar)[XB_TMO], 1u); break; } } } } while (0)
struct XcdBarrier { unsigned* bar; unsigned x; volatile LAS unsigned* st; };
__device__ __forceinline__ XcdBarrier xcd_barrier_post(unsigned* bar, volatile LAS unsigned* st) {
    XcdBarrier b; b.bar = bar; b.x = xb_xcc_id(); b.st = st;
    if (threadIdx.x == 0) (void)xb_add(&bar[XB_XCNT(b.x)], 1u);
    return b;
}
__device__ __forceinline__ void xcd_barrier_complete(unsigned* bar, unsigned x, unsigned& nloc, unsigned& nx) {
    const unsigned G = gridDim.x * gridDim.y * gridDim.z;
    unsigned sum, cnt, mine, sp = 0u;
    for (;;) {
        sum = 0u; cnt = 0u; mine = 0u;
#pragma unroll
        for (unsigned j = 0; j < 16; ++j) { const unsigned c = xb_ld(&bar[XB_XCNT(j)]); sum += c; cnt += (c > 0u) ? 1u : 0u; mine = (j == x) ? c : mine; }
        if (sum == G) break;
        __builtin_amdgcn_s_sleep(1);
        if ((++sp & 255u) == 0u) { if (xb_ld(&bar[XB_TMO])) break; if (sp > XB_SPIN_CAP) { atomicAdd(&bar[XB_TMO], 1u); break; } }
    }
    nloc = mine > 0u ? mine : 1u; nx = cnt > 0u ? cnt : 1u;
}
__device__ __forceinline__ void xcd_barrier(const XcdBarrier& b) {
    asm volatile("s_waitcnt vmcnt(0)" ::: "memory");
    __syncthreads();
    if (threadIdx.x == 0) {
        unsigned* bar = b.bar;
        __builtin_amdgcn_s_waitcnt(0);
        unsigned nloc = b.st[0], nx = b.st[1];
        if (nloc == 0u) { xcd_barrier_complete(bar, b.x, nloc, nx); b.st[0] = nloc; b.st[1] = nx; }
        const unsigned old = xb_add(&bar[XB_XSUB(b.x)], 1u);
        const unsigned gen = old / nloc;
        if (old + 1u == (gen + 1u) * nloc) {
            __builtin_amdgcn_fence(__ATOMIC_RELEASE, "agent");
            asm volatile("s_waitcnt vmcnt(0)" ::: "memory");
            const unsigned og = xb_add(&bar[XB_TOP], 1u);
            const unsigned tg = og / nx;
            if (og + 1u == (tg + 1u) * nx) xb_add(&bar[XB_TOPGEN], 1u);
            else XB_SPIN(xb_ld(&bar[XB_TOPGEN]) == tg, bar);
            __builtin_amdgcn_fence(__ATOMIC_ACQUIRE, "agent");
            xb_add(&bar[XB_XGEN(b.x)], 1u);
            asm volatile("s_waitcnt vmcnt(0)" ::: "memory");
        } else {
            XB_SPIN(xb_ld(&bar[XB_XGEN(b.x)]) == gen, bar);
            __builtin_amdgcn_fence(__ATOMIC_ACQUIRE, "agent");
            asm volatile("s_waitcnt vmcnt(0)" ::: "memory");
        }
    }
    __syncthreads();
}

__global__ void __launch_bounds__(512) fwd_kernel(Args a) {
    extern __shared__ __attribute__((aligned(16))) unsigned char lds_raw[];
    LAS unsigned char* lds = (LAS unsigned char*)lds_raw;
    unsigned char* ws = a.ws;
    const int G = gridDim.x, bx = blockIdx.x;
    float* hbuf = a.out;
    const int lo = a.ph_lo, hi = a.ph_hi;
#ifndef PHMASK
#define PHMASK 0x1fff
#endif
#define IN(k) (((PHMASK >> (k)) & 1) && lo <= (k) && (k) < hi)
    volatile LAS unsigned* xst = (volatile LAS unsigned*)(lds + LDS_BYTES - 16);
    XcdBarrier xbar; xbar.bar = (unsigned*)(ws + 65536); xbar.x = 0; xbar.st = xst;
    bool xposted = false;
#define SEAM(k) do { if ((k) + 1 < hi) { if ((k) == 0) { __syncthreads(); cg::this_grid().sync(); } \
        else { if (!xposted) { if (threadIdx.x == 0) { xst[0] = 0u; xst[1] = 0u; } __syncthreads(); xbar = xcd_barrier_post((unsigned*)(ws + 65536), xst); xposted = true; } xcd_barrier(xbar); } } } while (0)
    if (IN(0)) { if (bx == 0) { if (threadIdx.x < 8) ((unsigned*)ws)[64 * threadIdx.x] = 0u; for (int i = threadIdx.x; i < XCD_BAR_WORDS; i += 512) ((unsigned*)(ws + 65536))[i] = 0u; }
                 p0_prologue(a, lds); SEAM(0); }
    if (IN(1)) { pg8::Gemm g{(const bf16_t*)(ws + WS_XB), (const bf16_t*)(ws + WS_WUP1), M, NUP, D}; pg8::StaticOrder S; S.init(M, NUP, G, bx);
                 pg8::EpiSwiGLU E{(bf16_t*)(ws + WS_BIG), FF}; pg8::gemm_phase(lds, g, S, E); SEAM(1); }
    if (IN(2)) { pg8::Gemm g{(const bf16_t*)(ws + WS_BIG), (const bf16_t*)(ws + WS_WD1), M, D, FF}; pg8::StaticOrder S; S.init(M, D, G, bx);
                 pg8::EpiResid E{a.in[0], hbuf, ALPHA, 0.5f}; pg8::gemm_phase(lds, g, S, E); SEAM(2); }
    if (IN(3)) { ln_phase<true, true>(a, lds, hbuf, a.in[1], a.in[2]); SEAM(3); }
    if (IN(4)) { pg8::Gemm g{(const bf16_t*)(ws + WS_XB), (const bf16_t*)(ws + WS_WIN), M, NIN, D}; pg8::StaticOrder S; S.init(M, NIN, G, bx);
                 pg8::EpiBf16 E{(bf16_t*)(ws + WS_BIG), NIN}; pg8::gemm_phase(lds, g, S, E); SEAM(4); }
    if (IN(5)) { for (int u = bx; u < 2048 + 512; u += G) { if (u < 2048) ml_pre_unit(a, lds, u); else vt_unit(a, lds, u - 2048); } SEAM(5); }
    if (IN(6)) {
        ml_scan(a);
        float lam;
        { float s1 = 0.f, s2 = 0.f;
          for (int i = 0; i < 64; ++i) { s1 += a.in[10][i] * a.in[11][i]; s2 += a.in[12][i] * a.in[13][i]; }
          lam = expf(s1) - expf(s2) + LAMBDA_INIT; }
        unsigned* ctr = (unsigned*)ws;
        LAS int* bc = (LAS int*)(lds + att::OFF_BC);
        const int my = (int)(__builtin_amdgcn_s_getreg((3 << 11) | 20) & 7u);
        for (int k = 0; k < 8; ++k) { const int bh = (my + k) & 7;
            for (;;) { if (threadIdx.x == 0) *bc = (int)atomicAdd(ctr + 64 * bh, 1u);
                SYNC(); const int idx = *bc; SYNC();
                if (idx >= 128) break;
                att::attn_unit(a, lds, lam, bh, 127 - idx); } }
        SEAM(6);
    }
    if (IN(7)) {
        ml_out_phase(a, lds);
        SEAM(7);
    }
    if (IN(8)) { pg8::Gemm g{(const bf16_t*)(ws + WS_XB), (const bf16_t*)(ws + WS_WOUT), M, D, D}; pg8::StaticOrder S; S.init(M, D, G, bx);
                 pg8::EpiResid E{hbuf, hbuf, ALPHA, 1.0f}; pg8::gemm_phase(lds, g, S, E); SEAM(8); }
    if (IN(9)) { ln_phase<true, false>(a, lds, hbuf, a.in[17], a.in[18]); SEAM(9); }
    if (IN(10)) { pg8::Gemm g{(const bf16_t*)(ws + WS_XB), (const bf16_t*)(ws + WS_WUP2), M, NUP, D}; pg8::StaticOrder S; S.init(M, NUP, G, bx);
                  pg8::EpiSwiGLU E{(bf16_t*)(ws + WS_BIG), FF}; pg8::gemm_phase(lds, g, S, E); SEAM(10); }
    if (IN(11)) { pg8::Gemm g{(const bf16_t*)(ws + WS_BIG), (const bf16_t*)(ws + WS_WD2), M, D, FF}; pg8::StaticOrder S; S.init(M, D, G, bx);
                  pg8::EpiResid E{hbuf, hbuf, ALPHA, 0.5f}; pg8::gemm_phase(lds, g, S, E); SEAM(11); }
    if (IN(12)) { ln_phase<false, false>(a, lds, hbuf, a.in[21], a.in[22]); }
}

constexpr int N_PHASES = 13;

extern "C" void kernel_launch(void* const* d_in, const int* in_sizes, int n_in, void* d_out, int out_size, void* d_ws, size_t ws_size, hipStream_t stream) {
    static int grid = 0;
    if (grid == 0) {
        if (n_in != 24 || out_size != M * D || ws_size < WS_END) { fprintf(stderr, "kernel_launch: unexpected shapes n_in %d out %d ws %zu\n", n_in, out_size, ws_size); grid = -1; return; }
        int dev = 0, cus = 0, per_cu = 0;
        hipGetDevice(&dev);
        hipDeviceGetAttribute(&cus, hipDeviceAttributeMultiprocessorCount, dev);
        if (hipFuncSetAttribute((const void*)fwd_kernel, hipFuncAttributeMaxDynamicSharedMemorySize, LDS_BYTES) != hipSuccess) { fprintf(stderr, "hipFuncSetAttribute failed\n"); }
        hipOccupancyMaxActiveBlocksPerMultiprocessor(&per_cu, (const void*)fwd_kernel, 512, LDS_BYTES);
        (void)hipGetLastError();
        if (per_cu < 1) per_cu = 1;
        grid = cus * per_cu;
        if (grid > 256) grid = 256;
    }
    if (grid < 0) return;
    Args a{};
    for (int i = 0; i < 24; ++i) a.in[i] = (const float*)d_in[i];
    a.out = (float*)d_out; a.ws = (unsigned char*)d_ws;
#if ONE_LAUNCH
    a.ph_lo = 0; a.ph_hi = N_PHASES;
    void* args[] = {&a};
    hipError_t e = hipLaunchCooperativeKernel((const void*)fwd_kernel, dim3(grid), dim3(512), args, LDS_BYTES, stream);
    if (e != hipSuccess) fprintf(stderr, "cooperative launch failed: %s (grid %d)\n", hipGetErrorString(e), grid);
#else
    for (int ph = 0; ph < N_PHASES; ++ph) { a.ph_lo = ph; a.ph_hi = ph + 1;
        hipLaunchKernelGGL(fwd_kernel, dim3(grid), dim3(512), LDS_BYTES, stream, a); }
#endif
}
```

```cpp
#include <hip/hip_runtime.h>
#include <hip/hip_cooperative_groups.h>
#include <cstdio>
#include <cstdint>
namespace cg = cooperative_groups;

#ifndef ONE_LAUNCH
#define ONE_LAUNCH 1
#endif

#define LAS __attribute__((address_space(3)))
typedef unsigned short bf16_t;
typedef short bf16x8 __attribute__((ext_vector_type(8)));
typedef short s16x4 __attribute__((ext_vector_type(4)));
typedef float f32x4 __attribute__((ext_vector_type(4)));
typedef float f32x2 __attribute__((ext_vector_type(2)));
typedef float f32x16 __attribute__((ext_vector_type(16)));
typedef unsigned u32x4 __attribute__((ext_vector_type(4)));
typedef unsigned u32x2 __attribute__((ext_vector_type(2)));
typedef __bf16 bf16x2_t __attribute__((ext_vector_type(2)));

constexpr int SEQ = 16384, BATCH = 2, M = BATCH * SEQ, D = 1024, FF = 2816, NUP = 2 * FF, NIN = 3584, INC = 3592;
constexpr float LN_EPS = 1e-5f;
constexpr float ALPHA = 1.189207115002721f;
constexpr float LOG2E = 1.4426950408889634f;
constexpr float QSCALE = 0.125f * LOG2E;
constexpr float KSCALE = 0.08838834764831845f;
constexpr float LAMBDA_INIT = 0.2f;

constexpr size_t MiB = 1u << 20;
constexpr size_t WS_WUP1 = 1 * MiB, WS_WD1 = 12 * MiB, WS_WIN = 18 * MiB, WS_WOUT = 25 * MiB, WS_WUP2 = 27 * MiB, WS_WD2 = 38 * MiB;
constexpr size_t WS_WG = 44 * MiB;
constexpr size_t WS_GATE = 45 * MiB;
constexpr size_t WS_NLOC = 46 * MiB;
constexpr size_t WS_SCAL = 47 * MiB;
constexpr size_t WS_XB = 48 * MiB;
constexpr size_t WS_BIG = 112 * MiB;
constexpr size_t WS_MQ = 336 * MiB, WS_MK = 368 * MiB;
constexpr size_t WS_KV = 400 * MiB;
constexpr size_t WS_VT = 464 * MiB;
constexpr size_t WS_END = 498 * MiB;
constexpr int VSTR = SEQ + 64;

constexpr int LDS_BYTES = 147456;

__device__ __forceinline__ float bf2f(bf16_t x) { return __uint_as_float(((unsigned)x) << 16); }
__device__ __forceinline__ unsigned cvtpk(float lo, float hi) { f32x2 v = {lo, hi}; bf16x2_t b = __builtin_convertvector(v, bf16x2_t); return __builtin_bit_cast(unsigned, b); }
__device__ __forceinline__ bf16_t f2bf(float f) { return (bf16_t)(cvtpk(f, 0.f) & 0xffffu); }
#define DPPF(v, ctrl) __builtin_bit_cast(float, __builtin_amdgcn_update_dpp(0, __builtin_bit_cast(int, (v)), (ctrl), 0xF, 0xF, true))
__device__ __forceinline__ float row16_sum(float v) {
    v += DPPF(v, 0xB1);  v += DPPF(v, 0x4E);  v += DPPF(v, 0x141);  v += DPPF(v, 0x140);
    return v;
}
__device__ __forceinline__ float half32_sum(float v) {
    v = row16_sum(v);
    auto rr = __builtin_amdgcn_permlane16_swap(__float_as_uint(v), __float_as_uint(v), false, false);
    return __uint_as_float(rr[0]) + __uint_as_float(rr[1]);
}
__device__ __forceinline__ float wave_sum(float v) {
    v = half32_sum(v);
    auto rr = __builtin_amdgcn_permlane32_swap(__float_as_uint(v), __float_as_uint(v), false, false);
    return __uint_as_float(rr[0]) + __uint_as_float(rr[1]);
}
__device__ __forceinline__ float wave_max(float v) {
    v = fmaxf(v, DPPF(v, 0xB1)); v = fmaxf(v, DPPF(v, 0x4E)); v = fmaxf(v, DPPF(v, 0x141)); v = fmaxf(v, DPPF(v, 0x140));
    { auto rr = __builtin_amdgcn_permlane16_swap(__float_as_uint(v), __float_as_uint(v), false, false); v = fmaxf(__uint_as_float(rr[0]), __uint_as_float(rr[1])); }
    { auto rr = __builtin_amdgcn_permlane32_swap(__float_as_uint(v), __float_as_uint(v), false, false); v = fmaxf(__uint_as_float(rr[0]), __uint_as_float(rr[1])); }
    return v;
}
__device__ __forceinline__ float fexp(float x) { return __builtin_amdgcn_exp2f(x * LOG2E); }
__device__ __forceinline__ float fsigmoid(float x) { return __builtin_amdgcn_rcpf(1.f + __builtin_amdgcn_exp2f(-x * LOG2E)); }
__device__ __forceinline__ int crow(int r, int hi) { return (r & 3) + 8 * (r >> 2) + 4 * hi; }
#define MFMA32(a, b, c) __builtin_amdgcn_mfma_f32_32x32x16_bf16((a), (b), (c), 0, 0, 0)

namespace pg8 {
constexpr int BM = 256, BK = 64, HALF = 128, HTB = HALF * BK * 2, STAGE_BYTES = 8 * HTB, NXCD = 8, WGM = 8;
__host__ __device__ __forceinline__ int lds_byte(int r, int c) { const int st = (r >> 4) * 2 + (c >> 5), rr = r & 15, cc = c & 31, ob = rr * 64 + cc * 2; return st * 1024 + (ob ^ (((ob >> 9) & 1) << 5)); }
__host__ __device__ __forceinline__ void stage_rc(int b, int& R, int& C) { const int st = b / 1024, sb = b % 1024, swz = sb ^ (((sb >> 9) & 1) << 5); R = (st >> 1) * 16 + swz / 64; C = (st & 1) * 32 + (swz % 64) / 2; }
__host__ __device__ __forceinline__ int perm32(int rho) { const int n = rho >> 4, i = rho & 15; return 8 * (i >> 2) + 4 * n + (i & 3); }
struct Unit { int pm, pn; };
struct Gemm { const bf16_t* A; const bf16_t* Bt; int M, N, K; };
struct StaticOrder {
    int nM, nN, nwg, G, c;
    __host__ __device__ void init(int M_, int N_, int G_, int c_) { nM = M_ / BM; nN = N_ / BM; nwg = nM * nN; G = G_; c = c_; }
    __host__ __device__ bool next(int i, Unit& u) const {
        const long L = (long)i * G + c; if (L >= nwg) return false;
        int wgid = (int)L; { const int q = nwg / NXCD, r = nwg % NXCD, xcd = wgid % NXCD, off = wgid / NXCD; wgid = (xcd < r ? xcd * (q + 1) : r * (q + 1) + (xcd - r) * q) + off; }
        const int nig = WGM * nN, gid = wgid / nig, fm = gid * WGM, gsz = (nM - fm) < WGM ? (nM - fm) : WGM;
        u.pm = fm + ((wgid % nig) % gsz); u.pn = (wgid % nig) / gsz; return true;
    }
};
struct EpiBf16 {
    static constexpr bool PERM = true;
    bf16_t* O; int ldc;
    __device__ __forceinline__ void operator()(const f32x4 (&acc)[2][2][4][2], const Unit& u, int wr, int wc, int fr, int fq) const {
        const int row0 = u.pm * BM + wr * 64 + fr; const int col0 = u.pn * BM + wc * 32 + 8 * fq;
#pragma unroll
        for (int ai = 0; ai < 2; ++ai)
#pragma unroll
            for (int m = 0; m < 4; ++m) { bf16_t* rowp = O + (size_t)(row0 + ai * HALF + m * 16) * ldc + col0;
#pragma unroll
                for (int bj = 0; bj < 2; ++bj) { const f32x4 v0 = acc[ai][bj][m][0], v1 = acc[ai][bj][m][1];
                    u32x4 w; w.x = cvtpk(v0[0], v0[1]); w.y = cvtpk(v0[2], v0[3]); w.z = cvtpk(v1[0], v1[1]); w.w = cvtpk(v1[2], v1[3]);
                    *(u32x4*)(rowp + bj * HALF) = w; } }
    }
};
__device__ __forceinline__ float silu_mul(float a, float u) { return a * u * __builtin_amdgcn_rcpf(1.0f + __builtin_amdgcn_exp2f(-a * LOG2E)); }
struct EpiSwiGLU {
    static constexpr bool PERM = true;
    bf16_t* O; int ldc;
    __device__ __forceinline__ void operator()(const f32x4 (&acc)[2][2][4][2], const Unit& u, int wr, int wc, int fr, int fq) const {
        const int row0 = u.pm * BM + wr * 64 + fr; const int col0 = u.pn * HALF + wc * 32 + 8 * fq;
#pragma unroll
        for (int ai = 0; ai < 2; ++ai)
#pragma unroll
            for (int m = 0; m < 4; ++m) { bf16_t* rowp = O + (size_t)(row0 + ai * HALF + m * 16) * ldc + col0;
                const f32x4 a0 = acc[ai][0][m][0], a1 = acc[ai][0][m][1], u0 = acc[ai][1][m][0], u1 = acc[ai][1][m][1];
                u32x4 w; w.x = cvtpk(silu_mul(a0[0], u0[0]), silu_mul(a0[1], u0[1])); w.y = cvtpk(silu_mul(a0[2], u0[2]), silu_mul(a0[3], u0[3]));
                w.z = cvtpk(silu_mul(a1[0], u1[0]), silu_mul(a1[1], u1[1])); w.w = cvtpk(silu_mul(a1[2], u1[2]), silu_mul(a1[3], u1[3]));
                *(u32x4*)rowp = w; }
    }
};
struct EpiResid {
    static constexpr bool PERM = false;
    const float* res; float* out; float alpha, s;
    __device__ __forceinline__ void operator()(const f32x4 (&acc)[2][2][4][2], const Unit& u, int wr, int wc, int fr, int fq) const {
        const int row0 = u.pm * BM + wr * 64 + fr; const int col0 = u.pn * BM + wc * 32 + 4 * fq;
#pragma unroll
        for (int ai = 0; ai < 2; ++ai)
#pragma unroll
            for (int m = 0; m < 4; ++m) { const size_t off = (size_t)(row0 + ai * HALF + m * 16) * D + col0;
#pragma unroll
                for (int bj = 0; bj < 2; ++bj)
#pragma unroll
                    for (int n = 0; n < 2; ++n) { const size_t o = off + bj * HALF + n * 16; const f32x4 rv = *(const f32x4*)(res + o); *(f32x4*)(out + o) = rv * alpha + acc[ai][bj][m][n] * s; } }
    }
};

template <class Epi>
__device__ __forceinline__ void gemm_phase(LAS unsigned char* lds, const Gemm g, const StaticOrder& S, const Epi& E) {
    const int tid = threadIdx.x, wid = __builtin_amdgcn_readfirstlane(tid >> 6), lane = tid & 63, wr = wid >> 2, wc = wid & 3, fr = lane & 15, fq = lane >> 4;
    const int K = g.K, nt = K / BK;
    unsigned voffA[2], voffB[2];
#pragma unroll
    for (int i = 0; i < 2; ++i) { int R, C; stage_rc(tid * 16 + i * 8192, R, C); const int Rb = Epi::PERM ? ((R & ~31) + perm32(R & 31)) : R;
        voffA[i] = (unsigned)(R * K + C) * 2u; voffB[i] = (unsigned)(Rb * K + C) * 2u; }
    const size_t kstep = (size_t)(BK * 2);
    const size_t hstep = (size_t)HALF * K * 2;
    const size_t tstep = 2 * hstep;
    const unsigned ldsw = (unsigned)wid * 1024u;
    const int aoff = lds_byte(wr * 64 + fr, fq * 8), boff = lds_byte(wc * 32 + fr, fq * 8);
#define PG8_SA(b, h) (((b) * 2 + (h)) * HTB)
#define PG8_SB(b, h) ((4 + (b) * 2 + (h)) * HTB)
#define PG8_STAGE(bufoff, gbase, voff) do { _Pragma("unroll") for (int _i = 0; _i < 2; ++_i) \
        __builtin_amdgcn_global_load_lds((const unsigned*)((const char*)(gbase) + (voff)[_i]), (LAS unsigned*)(lds + (bufoff) + ldsw + _i * 8192), 16, 0, 0); } while (0)
#define PG8_LDA(dst, b, h) do { _Pragma("unroll") for (int m = 0; m < 4; ++m) _Pragma("unroll") for (int k = 0; k < 2; ++k) dst[m][k] = *(const LAS bf16x8*)(lds + PG8_SA(b, h) + aoff + m * 2048 + k * 1024); } while (0)
#define PG8_LDB(dst, b, h) do { _Pragma("unroll") for (int n = 0; n < 2; ++n) _Pragma("unroll") for (int k = 0; k < 2; ++k) dst[n][k] = *(const LAS bf16x8*)(lds + PG8_SB(b, h) + boff + n * 2048 + k * 1024); } while (0)
#define PG8_MMA(ai, bj, At, Bt) do { __builtin_amdgcn_s_setprio(1); _Pragma("unroll") for (int m = 0; m < 4; ++m) _Pragma("unroll") for (int n = 0; n < 2; ++n) _Pragma("unroll") for (int k = 0; k < 2; ++k) \
        acc[ai][bj][m][n] = __builtin_amdgcn_mfma_f32_16x16x32_bf16(Bt[n][k], At[m][k], acc[ai][bj][m][n], 0, 0, 0); __builtin_amdgcn_s_setprio(0); } while (0)
#define PG8_WAIT_V(n) asm volatile("s_waitcnt vmcnt(" #n ")" ::: "memory")
#define PG8_WAIT_L(n) asm volatile("s_waitcnt lgkmcnt(" #n ")" ::: "memory")
#define PG8_BAR __builtin_amdgcn_s_barrier()
#define PG8_SCHED __builtin_amdgcn_sched_barrier(0)
    Unit cur, nxt; int ui = 0;
    if (!S.next(0, cur)) return;
    f32x4 acc[2][2][4][2];
#pragma unroll
    for (int a = 0; a < 2; ++a)
#pragma unroll
        for (int b = 0; b < 2; ++b)
#pragma unroll
            for (int m = 0; m < 4; ++m)
#pragma unroll
                for (int n = 0; n < 2; ++n) acc[a][b][m][n] = (f32x4){0.f, 0.f, 0.f, 0.f};
    bf16x8 At[4][2], B0[2][2], B1[2][2];
    const char* cA = (const char*)g.A + (size_t)cur.pm * tstep; const char* cB = (const char*)g.Bt + (size_t)cur.pn * tstep;
    PG8_STAGE(PG8_SB(0, 0), cB, voffB); PG8_STAGE(PG8_SB(0, 1), cB + hstep, voffB); PG8_STAGE(PG8_SA(0, 0), cA, voffA); PG8_STAGE(PG8_SA(0, 1), cA + hstep, voffA);
    if (wr == 1) PG8_BAR;
    PG8_WAIT_V(2); PG8_BAR;
    PG8_STAGE(PG8_SB(1, 0), cB + kstep, voffB); PG8_STAGE(PG8_SA(1, 0), cA + kstep, voffA); PG8_STAGE(PG8_SB(1, 1), cB + hstep + kstep, voffB);
    PG8_WAIT_V(6); PG8_BAR;
    for (;;) {
        const bool has_next = S.next(ui + 1, nxt);
        const char* nA = has_next ? (const char*)g.A + (size_t)nxt.pm * tstep : cA; const char* nB = has_next ? (const char*)g.Bt + (size_t)nxt.pn * tstep : cB;
        for (int t = 0; t < nt; t += 2) {
            const bool last = (t == nt - 2);
            const char* a1 = cA + (size_t)(t + 1) * kstep;
            const char* a2 = last ? nA : cA + (size_t)(t + 2) * kstep; const char* b2 = last ? nB : cB + (size_t)(t + 2) * kstep;
            const char* a3 = a2 + kstep; const char* b3 = b2 + kstep;
            PG8_LDB(B0, 0, 0); PG8_LDB(B1, 0, 1); PG8_SCHED; PG8_LDA(At, 0, 0); PG8_STAGE(PG8_SA(1, 1), a1 + hstep, voffA);
            PG8_WAIT_V(8); PG8_WAIT_L(0); PG8_BAR; PG8_MMA(0, 0, At, B0); PG8_MMA(0, 1, At, B1); PG8_BAR; PG8_SCHED;
            PG8_LDA(At, 0, 1); PG8_STAGE(PG8_SB(0, 0), b2, voffB); PG8_STAGE(PG8_SB(0, 1), b2 + hstep, voffB); PG8_STAGE(PG8_SA(0, 0), a2, voffA);
            PG8_WAIT_V(8); PG8_WAIT_L(0); PG8_BAR; PG8_MMA(1, 0, At, B0); PG8_MMA(1, 1, At, B1); PG8_BAR; PG8_SCHED;
            PG8_LDB(B0, 1, 0); PG8_LDB(B1, 1, 1); PG8_SCHED; PG8_LDA(At, 1, 0); PG8_STAGE(PG8_SA(0, 1), a2 + hstep, voffA);
            PG8_WAIT_V(8); PG8_WAIT_L(0); PG8_BAR; PG8_MMA(0, 0, At, B0); PG8_MMA(0, 1, At, B1); PG8_BAR; PG8_SCHED;
            PG8_LDA(At, 1, 1); PG8_STAGE(PG8_SB(1, 0), b3, voffB); PG8_STAGE(PG8_SB(1, 1), b3 + hstep, voffB); PG8_STAGE(PG8_SA(1, 0), a3, voffA);
            PG8_WAIT_V(8); PG8_WAIT_L(0); PG8_BAR; PG8_MMA(1, 0, At, B0); PG8_MMA(1, 1, At, B1); PG8_BAR; PG8_SCHED;
        }
        if (wr == 0) PG8_BAR;
        E(acc, cur, wr, wc, fr, fq);
        if (!has_next) break;
#pragma unroll
        for (int a = 0; a < 2; ++a)
#pragma unroll
            for (int b = 0; b < 2; ++b)
#pragma unroll
                for (int m = 0; m < 4; ++m)
#pragma unroll
                    for (int n = 0; n < 2; ++n) acc[a][b][m][n] = (f32x4){0.f, 0.f, 0.f, 0.f};
        cur = nxt; cA = nA; cB = nB; ++ui;
        if (wr == 1) PG8_BAR;
    }
    PG8_WAIT_V(0);
    PG8_BAR;
#undef PG8_SA
#undef PG8_SB
#undef PG8_STAGE
#undef PG8_LDA
#undef PG8_LDB
#undef PG8_MMA
#undef PG8_WAIT_V
#undef PG8_WAIT_L
#undef PG8_BAR
#undef PG8_SCHED
}
}

struct Args {
    const float* in[24];
    float* out;
    unsigned char* ws;
    int ph_lo, ph_hi;
};

#define SYNC() __syncthreads()

__device__ __forceinline__ void transpose_item(const float* W, int K, int ldw, int src_n0, bf16_t* WT, int dst_n0, int k0, float scale, LAS float* scr, int lane) {
#pragma unroll 8
    for (int i = 0; i < 32; ++i) { const int kk = 2 * i + (lane >> 5); scr[kk * 33 + (lane & 31)] = W[(size_t)(k0 + kk) * ldw + src_n0 + (lane & 31)]; }
    asm volatile("s_waitcnt lgkmcnt(0)" ::: "memory");
    const int c = lane & 7;
#pragma unroll
    for (int j = 0; j < 4; ++j) { const int n = (lane >> 3) + 8 * j; const LAS float* s = scr + (8 * c) * 33 + n;
        u32x4 o; o.x = cvtpk(s[0 * 33] * scale, s[1 * 33] * scale); o.y = cvtpk(s[2 * 33] * scale, s[3 * 33] * scale); o.z = cvtpk(s[4 * 33] * scale, s[5 * 33] * scale); o.w = cvtpk(s[6 * 33] * scale, s[7 * 33] * scale);
        *(u32x4*)(WT + (size_t)(dst_n0 + n) * K + k0 + 8 * c) = o; }
    asm volatile("s_waitcnt lgkmcnt(0)" ::: "memory");
}
__device__ __forceinline__ int up_src_col(int n0) { const int pn = n0 >> 8, j = n0 & 255; return (j < 128) ? pn * 128 + j : FF + pn * 128 + (j - 128); }

__device__ __forceinline__ void p0_prologue(const Args& a, LAS unsigned char* lds) {
    const int tid = threadIdx.x, lane = tid & 63, wid = tid >> 6;
    LAS float* scr = (LAS float*)(lds + wid * 16384);
    const int gw = blockIdx.x * 8 + wid, NGW = gridDim.x * 8;
    unsigned char* ws = a.ws;
    constexpr int I_UP = 16 * (NUP / 32), I_DN = (FF / 64) * (D / 32), I_IN = 16 * (NIN / 32), I_OUT = 16 * 32;
    constexpr int NITEMS = 2 * I_UP + 2 * I_DN + I_IN + I_OUT;
    for (int it = gw; it < NITEMS; it += NGW) {
        int r = it;
        if (r < 2 * I_UP) { const int which = r / I_UP; r -= which * I_UP; const int nblk = NUP / 32, kb = r / nblk, nb = r % nblk;
            transpose_item(a.in[which ? 19 : 3], D, NUP, up_src_col(32 * nb), (bf16_t*)(ws + (which ? WS_WUP2 : WS_WUP1)), 32 * nb, 64 * kb, 1.f, scr, lane); continue; }
        r -= 2 * I_UP;
        if (r < 2 * I_DN) { const int which = r / I_DN; r -= which * I_DN; const int nblk = D / 32, kb = r / nblk, nb = r % nblk;
            transpose_item(a.in[which ? 20 : 4], FF, D, 32 * nb, (bf16_t*)(ws + (which ? WS_WD2 : WS_WD1)), 32 * nb, 64 * kb, 1.f, scr, lane); continue; }
        r -= 2 * I_DN;
        if (r < I_IN) { const int nblk = NIN / 32, kb = r / nblk, nb = r % nblk;
            transpose_item(a.in[5], D, INC, 32 * nb, (bf16_t*)(ws + WS_WIN), 32 * nb, 64 * kb, (32 * nb < 512) ? QSCALE : 1.f, scr, lane); continue; }
        r -= I_IN;
        { const int nblk = D / 32, kb = r / nblk, nb = r % nblk;
            transpose_item(a.in[16], D, D, 32 * nb, (bf16_t*)(ws + WS_WOUT), 32 * nb, 64 * kb, 1.f, scr, lane); }
    }
    { float* wg = (float*)(ws + WS_WG); const float* win = a.in[5];
      for (int i = blockIdx.x * 512 + tid; i < 8 * D; i += gridDim.x * 512) { const int j = i >> 10, k = i & 1023; wg[i] = win[(size_t)k * INC + NIN + j]; } }
    { const f32x4* x4 = (const f32x4*)a.in[0]; u32x4* xb = (u32x4*)(ws + WS_XB);
      const size_t n8 = (size_t)M * D / 8;
      const size_t stride = (size_t)gridDim.x * 512;
      for (size_t i = (size_t)blockIdx.x * 512 + tid; i < n8; i += 4 * stride) { f32x4 v[4][2];
#pragma unroll
          for (int k = 0; k < 4; ++k) { const size_t ii = i + k * stride; if (ii < n8) { v[k][0] = x4[2 * ii]; v[k][1] = x4[2 * ii + 1]; } }
#pragma unroll
          for (int k = 0; k < 4; ++k) { const size_t ii = i + k * stride; if (ii < n8) { u32x4 o; o.x = cvtpk(v[k][0][0], v[k][0][1]); o.y = cvtpk(v[k][0][2], v[k][0][3]); o.z = cvtpk(v[k][1][0], v[k][1][1]); o.w = cvtpk(v[k][1][2], v[k][1][3]); xb[ii] = o; } } } }
}

template <bool WRITE_BF16, bool GATES>
__device__ __forceinline__ void ln_phase(const Args& a, LAS unsigned char* lds, float* hbuf, const float* g, const float* b) {
    const int tid = threadIdx.x, lane = tid & 63, wid = tid >> 6;
    LAS float* wgs = (LAS float*)lds;
    if (GATES) { const float* wg = (const float*)(a.ws + WS_WG); for (int i = tid; i < 8 * D; i += 512) wgs[i] = wg[i]; SYNC(); }
    f32x4 gv[4], bv[4];
#pragma unroll
    for (int j = 0; j < 4; ++j) { gv[j] = *(const f32x4*)(g + 4 * lane + 256 * j); bv[j] = *(const f32x4*)(b + 4 * lane + 256 * j); }
    bf16_t* xb = (bf16_t*)(a.ws + WS_XB); float* gate = (float*)(a.ws + WS_GATE);
    const int gw = blockIdx.x * 8 + wid, NGW = gridDim.x * 8;
    for (int m0 = 2 * gw; m0 < M; m0 += 2 * NGW) {
        f32x4 vv[2][4];
#pragma unroll
        for (int rr = 0; rr < 2; ++rr) { const f32x4* xr = (const f32x4*)(hbuf + (size_t)(m0 + rr) * D) + lane;
#pragma unroll
            for (int j = 0; j < 4; ++j) vv[rr][j] = xr[64 * j]; }
#pragma unroll
        for (int rr = 0; rr < 2; ++rr) {
            const int m = m0 + rr;
            f32x4* xr = (f32x4*)(hbuf + (size_t)m * D) + lane;
            f32x4 v[4]; float s = 0.f;
#pragma unroll
            for (int j = 0; j < 4; ++j) { v[j] = vv[rr][j]; s += (v[j][0] + v[j][1]) + (v[j][2] + v[j][3]); }
            const float mean = wave_sum(s) * (1.f / D); float s2 = 0.f;
#pragma unroll
            for (int j = 0; j < 4; ++j) { v[j] = v[j] - mean; s2 += (v[j][0] * v[j][0] + v[j][1] * v[j][1]) + (v[j][2] * v[j][2] + v[j][3] * v[j][3]); }
            const float rstd = 1.f / sqrtf(wave_sum(s2) * (1.f / D) + LN_EPS);
#pragma unroll
            for (int j = 0; j < 4; ++j) { v[j] = v[j] * rstd * gv[j] + bv[j]; xr[64 * j] = v[j]; }
            if (WRITE_BF16) { u32x2* o8 = (u32x2*)(xb + (size_t)m * D) + lane;
#pragma unroll
                for (int j = 0; j < 4; ++j) { u32x2 o; o.x = cvtpk(v[j][0], v[j][1]); o.y = cvtpk(v[j][2], v[j][3]); o8[64 * j] = o; } }
            if (GATES) {
                float p[8];
#pragma unroll
                for (int q = 0; q < 8; ++q) { float acc = 0.f;
#pragma unroll
                    for (int j = 0; j < 4; ++j) { const f32x4 w = *(const LAS f32x4*)(wgs + q * D + 4 * lane + 256 * j); acc += (v[j][0] * w[0] + v[j][1] * w[1]) + (v[j][2] * w[2] + v[j][3] * w[3]); }
                    p[q] = wave_sum(acc); }
                if (lane < 8) { float val = p[0];
#pragma unroll
                    for (int q = 1; q < 8; ++q) val = (lane == q) ? p[q] : val;
                    const float bias = (lane < 4) ? a.in[8][lane] : a.in[9][lane - 4];
                    gate[(size_t)m * 8 + lane] = val + bias; }
            }
        }
    }
    if (GATES) SYNC();
}

__device__ __forceinline__ void ml_pre_unit(const Args& a, LAS unsigned char* lds, int unit) {
    const int tid = threadIdx.x, lane = tid & 63, wid = tid >> 6, l32 = lane & 31, hi = lane >> 5;
    const int bh = unit >> 8, c = unit & 255, b = bh >> 2, h = bh & 3;
    const size_t row0 = (size_t)b * SEQ + c * 64;
    LAS bf16_t* Kt = (LAS bf16_t*)lds;
    LAS bf16_t* Vw = (LAS bf16_t*)(lds + 18432);
    LAS float* wl = (LAS float*)(lds + 36864);
    unsigned char* ws = a.ws;
    const bf16_t* proj = (const bf16_t*)(ws + WS_BIG);
    float* scal = (float*)(ws + WS_SCAL);
    if (wid == 0) {
        const float* gp = (const float*)(ws + WS_GATE) + (row0 + lane) * 8;
        const float ii = gp[h], fi = gp[4 + h];
        const float lf = fminf(fi, 0.f) - log1pf(expf(-fabsf(fi)));
        float bc = lf;
#pragma unroll
        for (int o = 1; o < 64; o <<= 1) { const float t = __shfl_up(bc, o); if (lane >= o) bc += t; }
        const float blast = __shfl(bc, 63);
        const float gg = blast - bc + ii;
        const float mloc = wave_max(gg);
        wl[lane] = expf(gg - mloc);
        scal[6144 + (size_t)bh * SEQ + c * 64 + lane] = bc;
        if (lane == 0) { scal[unit] = blast; scal[2048 + unit] = mloc; }
    }
    const float* cw = a.in[6]; const float* cb = a.in[7];
    u32x4 cu[4][4];
#pragma unroll
    for (int it = 0; it < 4; ++it) {
        const int which = it >> 1, l = (tid >> 4) + 32 * (it & 1), dg = tid & 15;
        const int ch = which * 512 + h * 128 + 8 * dg;
#pragma unroll
        for (int j = 0; j < 4; ++j) { const int sl = c * 64 + l - 3 + j;
            cu[it][j] = (sl >= 0) ? *(const u32x4*)(proj + ((size_t)b * SEQ + sl) * NIN + 1536 + ch) : (u32x4){0u, 0u, 0u, 0u}; }
    }
    u32x4 vu[2];
#pragma unroll
    for (int it = 0; it < 2; ++it) { const int l = (tid >> 4) + 32 * it, dg = tid & 15; vu[it] = *(const u32x4*)(proj + (row0 + l) * NIN + 2560 + h * 128 + 8 * dg); }
#pragma unroll
    for (int it = 0; it < 4; ++it) {
        const int which = it >> 1, l = (tid >> 4) + 32 * (it & 1), dg = tid & 15;
        const int ch = which * 512 + h * 128 + 8 * dg;
        float o[8];
#pragma unroll
        for (int e = 0; e < 8; ++e) o[e] = cb[ch + e];
#pragma unroll
        for (int j = 0; j < 4; ++j) { const u32x4 u = cu[it][j];
            const f32x4 w0 = *(const f32x4*)(cw + j * 1024 + ch), w1 = *(const f32x4*)(cw + j * 1024 + ch + 4);
            o[0] += __uint_as_float(u.x << 16) * w0[0]; o[1] += __uint_as_float(u.x & 0xffff0000u) * w0[1];
            o[2] += __uint_as_float(u.y << 16) * w0[2]; o[3] += __uint_as_float(u.y & 0xffff0000u) * w0[3];
            o[4] += __uint_as_float(u.z << 16) * w1[0]; o[5] += __uint_as_float(u.z & 0xffff0000u) * w1[1];
            o[6] += __uint_as_float(u.w << 16) * w1[2]; o[7] += __uint_as_float(u.w & 0xffff0000u) * w1[3]; }
        const float sc = which ? KSCALE : 1.f;
#pragma unroll
        for (int e = 0; e < 8; ++e) o[e] = o[e] * fsigmoid(o[e]) * sc;
        u32x4 w; w.x = cvtpk(o[0], o[1]); w.y = cvtpk(o[2], o[3]); w.z = cvtpk(o[4], o[5]); w.w = cvtpk(o[6], o[7]);
        bf16_t* dst = (bf16_t*)(ws + (which ? WS_MK : WS_MQ)) + (row0 + l) * 512 + h * 128 + 8 * dg;
        *(u32x4*)dst = w;
        if (which) {
#pragma unroll
            for (int e = 0; e < 8; ++e) Kt[(8 * dg + e) * 72 + l] = f2bf(o[e]);
        }
    }
    SYNC();
#pragma unroll
    for (int it = 0; it < 2; ++it) {
        const int l = (tid >> 4) + 32 * it, dg = tid & 15;
        const u32x4 u = vu[it];
        const float w = wl[l];
        float v[8] = {__uint_as_float(u.x << 16), __uint_as_float(u.x & 0xffff0000u), __uint_as_float(u.y << 16), __uint_as_float(u.y & 0xffff0000u),
                      __uint_as_float(u.z << 16), __uint_as_float(u.z & 0xffff0000u), __uint_as_float(u.w << 16), __uint_as_float(u.w & 0xffff0000u)};
#pragma unroll
        for (int e = 0; e < 8; ++e) Vw[(8 * dg + e) * 72 + l] = f2bf(v[e] * w);
    }
    SYNC();
    {
        const int vb = wid >> 1, kb0 = 2 * (wid & 1);
        bf16_t* kv = (bf16_t*)(ws + WS_KV) + (size_t)unit * 16384;
#pragma unroll
        for (int kk = 0; kk < 2; ++kk) { const int kb = kb0 + kk; f32x16 acc = {};
#pragma unroll
            for (int ks = 0; ks < 4; ++ks) { const bf16x8 A = *(const LAS bf16x8*)(Vw + (32 * vb + l32) * 72 + 16 * ks + 8 * hi); const bf16x8 B = *(const LAS bf16x8*)(Kt + (32 * kb + l32) * 72 + 16 * ks + 8 * hi);
                acc = MFMA32(A, B, acc); }
#pragma unroll
            for (int r = 0; r < 16; ++r) kv[(32 * vb + crow(r, hi)) * 128 + 32 * kb + l32] = f2bf(acc[r]); }
    }
    if (tid < 128) { float s = 0.f;
#pragma unroll 8
        for (int l = 0; l < 64; ++l) s += wl[l] * bf2f(Kt[tid * 72 + l]);
        ((float*)(ws + WS_NLOC))[(size_t)unit * 128 + tid] = s; }
    SYNC();
}
__device__ __forceinline__ void vt_unit(const Args& a, LAS unsigned char* lds, int tv) {
    const int tid = threadIdx.x;
    LAS bf16_t* T = (LAS bf16_t*)lds;
    const bf16_t* proj = (const bf16_t*)(a.ws + WS_BIG);
    const size_t r0 = (size_t)tv * 64; const int b = tv >> 8, s0 = (tv & 255) * 64;
#pragma unroll
    for (int i = 0; i < 8; ++i) { const int id = tid + 512 * i, row = id >> 6, ch = id & 63;
        *(LAS u32x4*)(T + row * 520 + 8 * ch) = *(const u32x4*)(proj + (r0 + row) * NIN + 1024 + 8 * ch); }
    SYNC();
    { const int h = tid >> 7, d = tid & 127;
      bf16_t* dst = (bf16_t*)(a.ws + WS_VT) + ((size_t)(b * 4 + h) * 128 + d) * VSTR + s0;
#pragma unroll
      for (int i = 0; i < 8; ++i) { unsigned w[4];
#pragma unroll
          for (int e = 0; e < 4; ++e) { const int k0 = 16 * (i >> 1) + 4 * (i & 1) + ((2 * e) & 3) + 8 * (e >> 1);
              w[e] = (unsigned)T[k0 * 520 + tid] | ((unsigned)T[(k0 + 1) * 520 + tid] << 16); }
          *(u32x4*)(dst + 8 * i) = (u32x4){w[0], w[1], w[2], w[3]}; } }
    SYNC();
}

__device__ __forceinline__ void ml_scan(const Args& a) {
    const int tid = threadIdx.x;
    unsigned char* ws = a.ws;
    const float* scal = (const float*)(ws + WS_SCAL);
    for (int g = blockIdx.x; g < 130; g += gridDim.x) {
        if (g < 128) {
            const int gid = g * 512 + tid, bh = gid >> 13, w = gid & 8191;
            unsigned* p = (unsigned*)(ws + WS_KV) + (size_t)bh * 256 * 8192 + w;
            float C0 = 0.f, C1 = 0.f, m = 0.f;
            for (int c0 = 0; c0 < 256; c0 += 8) {
                unsigned kv[8];
#pragma unroll
                for (int i = 0; i < 8; ++i) kv[i] = p[(size_t)(c0 + i) * 8192];
#pragma unroll
                for (int i = 0; i < 8; ++i) {
                    const float bl = scal[bh * 256 + c0 + i], ml = scal[2048 + bh * 256 + c0 + i];
                    const float mn = fmaxf(bl + m, ml), dec = expf(bl + m - mn), sc = expf(ml - mn);
                    p[(size_t)(c0 + i) * 8192] = cvtpk(C0, C1);
                    C0 = dec * C0 + sc * __uint_as_float(kv[i] << 16); C1 = dec * C1 + sc * __uint_as_float(kv[i] & 0xffff0000u); m = mn;
                }
            }
        } else {
            const int gid = (g - 128) * 512 + tid, bh = gid >> 7, k = gid & 127;
            float* p = (float*)(ws + WS_NLOC) + (size_t)bh * 256 * 128 + k;
            float* mprev = (float*)(ws + WS_SCAL) + 4096;
            float n = 0.f, m = 0.f;
            for (int c = 0; c < 256; ++c) {
                const float bl = scal[bh * 256 + c], ml = scal[2048 + bh * 256 + c];
                const float mn = fmaxf(bl + m, ml), dec = expf(bl + m - mn), sc = expf(ml - mn);
                const float nl = p[c * 128];
                p[c * 128] = n; if (k == 0) mprev[bh * 256 + c] = m;
                n = dec * n + sc * nl; m = mn;
            }
        }
    }
}

__device__ __forceinline__ void ml_out_phase(const Args& a, LAS unsigned char* lds) {
    const int tid = threadIdx.x, lane = tid & 63, wid = tid >> 6, l32 = lane & 31, hi = lane >> 5;
    unsigned char* ws = a.ws;
    LAS bf16_t* Qs = (LAS bf16_t*)lds;
    LAS bf16_t* Ks = (LAS bf16_t*)(lds + 17408);
    LAS bf16_t* Vt = (LAS bf16_t*)(lds + 34816);
    LAS bf16_t* Cs = (LAS bf16_t*)(lds + 53248);
    LAS float* Hs = (LAS float*)(lds + 88064);
    LAS float* bs = (LAS float*)(lds + 121856);
    LAS float* lis = bs + 64;
    LAS float* ns = bs + 128;
    LAS float* wsf = bs + 256 + wid * 64;
    const bf16_t* proj = (const bf16_t*)(ws + WS_BIG);
    const float* scal = (const float*)(ws + WS_SCAL);
    const int G = gridDim.x;
    int unit = blockIdx.x;
    if (unit >= 2048) return;
    u32x4 rq[2], rk[2], rv[2], rc[4]; float rs0 = 0.f, rs1 = 0.f, rmp;
#define MLO_LOAD(UU) do { const int _bh = (UU) >> 8, _c = (UU) & 255, _b = _bh >> 2, _h = _bh & 3; const size_t _r0 = (size_t)_b * SEQ + _c * 64; \
        _Pragma("unroll") for (int i = 0; i < 2; ++i) { const int id = tid + 512 * i, row = id >> 4, ch = id & 15; \
            rq[i] = *(const u32x4*)((const bf16_t*)(ws + WS_MQ) + (_r0 + row) * 512 + _h * 128 + 8 * ch); \
            rk[i] = *(const u32x4*)((const bf16_t*)(ws + WS_MK) + (_r0 + row) * 512 + _h * 128 + 8 * ch); \
            } \
        _Pragma("unroll") for (int i = 0; i < 4; ++i) { const int id = tid + 512 * i, row = id >> 4, ch = id & 15; \
            rc[i] = *(const u32x4*)((const bf16_t*)(ws + WS_KV) + (size_t)(UU) * 16384 + row * 128 + 8 * ch); } \
        if (tid < 64) { rs0 = scal[6144 + (size_t)_bh * SEQ + _c * 64 + tid]; rs1 = ((const float*)(ws + WS_GATE))[(_r0 + tid) * 8 + _h]; } \
        else if (tid < 192) { rs0 = ((const float*)(ws + WS_NLOC))[(size_t)(UU) * 128 + tid - 64]; } \
        rmp = scal[4096 + (UU)]; } while (0)
#define MLO_LOADV(UU) do { const int _bh = (UU) >> 8, _c = (UU) & 255, _b = _bh >> 2, _h = _bh & 3; const size_t _r0 = (size_t)_b * SEQ + _c * 64; \
        _Pragma("unroll") for (int i = 0; i < 2; ++i) { const int id = tid + 512 * i, row = id >> 4, ch = id & 15; rv[i] = *(const u32x4*)(proj + (_r0 + row) * NIN + 2560 + _h * 128 + 8 * ch); } } while (0)
    MLO_LOAD(unit); MLO_LOADV(unit);
    const float g0 = a.in[15][lane], g1 = a.in[15][lane + 64];
    for (; unit < 2048; unit += G) {
    int tq = threadIdx.x; asm volatile("" : "+v"(tq));
    const int tid = tq, lane = tid & 63, wid = tid >> 6, l32 = lane & 31, hi = lane >> 5;
    LAS float* wsf = bs + 256 + wid * 64;
    const int bh = unit >> 8, c = unit & 255, b = bh >> 2, h = bh & 3;
    const size_t row0 = (size_t)b * SEQ + c * 64;
#pragma unroll
    for (int i = 0; i < 4; ++i) { const int id = tid + 512 * i, row = id >> 4, ch = id & 15;
        *(LAS u32x4*)(Cs + row * 136 + 8 * ch) = rc[i]; }
#pragma unroll
    for (int i = 0; i < 2; ++i) { const int id = tid + 512 * i, row = id >> 4, ch = id & 15;
        *(LAS u32x4*)(Qs + row * 136 + 8 * ch) = rq[i];
        *(LAS u32x4*)(Ks + row * 136 + 8 * ch) = rk[i];
        const unsigned uu[4] = {rv[i].x, rv[i].y, rv[i].z, rv[i].w};
#pragma unroll
        for (int e = 0; e < 4; ++e) { Vt[(8 * ch + 2 * e) * 72 + row] = (bf16_t)(uu[e] & 0xffffu); Vt[(8 * ch + 2 * e + 1) * 72 + row] = (bf16_t)(uu[e] >> 16); } }
    if (tid < 64) { bs[tid] = rs0; lis[tid] = rs1; }
    else if (tid < 192) { ns[tid - 64] = rs0; }
    const float mprev = rmp;
    asm volatile("s_waitcnt lgkmcnt(0)" ::: "memory"); __builtin_amdgcn_s_barrier(); asm volatile("" ::: "memory");
    unsigned ogp[8];
#pragma unroll
    for (int i = 0; i < 8; ++i) { const bf16_t* op = proj + (row0 + 8 * wid + i) * NIN + 3072 + h * 128; ogp[i] = (unsigned)op[lane] | ((unsigned)op[lane + 64] << 16); }
    if (unit + G < 2048) MLO_LOAD(unit + G);
    const int jb = wid & 1, vb = wid >> 1, j = 32 * jb + l32;
    f32x16 st[2];
#pragma unroll
    for (int sb = 0; sb < 2; ++sb) { st[sb] = (f32x16){};
        if (sb <= jb) {
#pragma unroll
            for (int ks = 0; ks < 8; ++ks) { const bf16x8 A = *(const LAS bf16x8*)(Ks + (32 * sb + l32) * 136 + 16 * ks + 8 * hi); const bf16x8 B = *(const LAS bf16x8*)(Qs + (32 * jb + l32) * 136 + 16 * ks + 8 * hi);
                st[sb] = MFMA32(A, B, st[sb]); } } }
    __builtin_amdgcn_sched_barrier(0);
    __builtin_amdgcn_sched_barrier(0);
    const float bj = bs[j], m_inter = bj + mprev;
    float mx = -INFINITY;
#pragma unroll
    for (int sb = 0; sb < 2; ++sb)
#pragma unroll
        for (int r = 0; r < 16; ++r) { const int s = 32 * sb + crow(r, hi); const float dm = bj - bs[s] + lis[s]; mx = fmaxf(mx, (s <= j) ? dm : -INFINITY); }
    mx = fmaxf(mx, __shfl_xor(mx, 32));
    __builtin_amdgcn_sched_barrier(0);
    __builtin_amdgcn_sched_barrier(0);
    const float mj = fmaxf(m_inter, mx);
    float rowsum = 0.f; unsigned pk[2][8];
#pragma unroll
    for (int sb = 0; sb < 2; ++sb) { float sw[16];
#pragma unroll
        for (int r = 0; r < 16; ++r) { const int s = 32 * sb + crow(r, hi); const float ew = fexp(bj - bs[s] + lis[s] - mj); const float wgt = (s <= j) ? ew : 0.f; sw[r] = st[sb][r] * wgt; rowsum += sw[r]; }
#pragma unroll
        for (int e = 0; e < 8; ++e) pk[sb][e] = cvtpk(sw[2 * e], sw[2 * e + 1]);
        __builtin_amdgcn_sched_barrier(0); }
    rowsum += __shfl_xor(rowsum, 32);
    __builtin_amdgcn_sched_barrier(0);
    __builtin_amdgcn_sched_barrier(0);
    float nq = 0.f;
#pragma unroll
    for (int k8 = 0; k8 < 8; ++k8) { const u32x4 u = *(const LAS u32x4*)(Qs + j * 136 + 64 * hi + 8 * k8); const LAS float* np = ns + 64 * hi + 8 * k8;
        nq += __uint_as_float(u.x << 16) * np[0] + __uint_as_float(u.x & 0xffff0000u) * np[1] + __uint_as_float(u.y << 16) * np[2] + __uint_as_float(u.y & 0xffff0000u) * np[3]
            + __uint_as_float(u.z << 16) * np[4] + __uint_as_float(u.z & 0xffff0000u) * np[5] + __uint_as_float(u.w << 16) * np[6] + __uint_as_float(u.w & 0xffff0000u) * np[7]; }
    nq += __shfl_xor(nq, 32);
    __builtin_amdgcn_sched_barrier(0);
    __builtin_amdgcn_sched_barrier(0);
    const float inter_w = fexp(m_inter - mj);
    const float den = rowsum + inter_w * nq;
    const float dscale = 1.f / fmaxf(fabsf(den), fexp(-mj));
    if (hi == 0) { wsf[l32] = dscale; wsf[32 + l32] = inter_w * dscale; }
    asm volatile("s_waitcnt lgkmcnt(0)" ::: "memory");
    __builtin_amdgcn_sched_barrier(0);
    __builtin_amdgcn_sched_barrier(0);
    f32x16 a1 = {}, a2 = {};
#pragma unroll
    for (int sb = 0; sb < 2; ++sb)
        if (sb <= jb) {
#pragma unroll
            for (int jj = 0; jj < 2; ++jj) { const bf16x8 A = __builtin_bit_cast(bf16x8, (u32x4){pk[sb][4 * jj], pk[sb][4 * jj + 1], pk[sb][4 * jj + 2], pk[sb][4 * jj + 3]});
                const LAS bf16_t* vp = Vt + (32 * vb + l32) * 72 + 32 * sb + 16 * jj + 4 * hi;
                const u32x2 lo = *(const LAS u32x2*)vp, hi2 = *(const LAS u32x2*)(vp + 8);
                const bf16x8 B = __builtin_bit_cast(bf16x8, (u32x4){lo.x, lo.y, hi2.x, hi2.y});
                a1 = MFMA32(A, B, a1); } }
#pragma unroll
    for (int ks = 0; ks < 8; ++ks) { const bf16x8 A = *(const LAS bf16x8*)(Qs + (32 * jb + l32) * 136 + 16 * ks + 8 * hi); const bf16x8 B = *(const LAS bf16x8*)(Cs + (32 * vb + l32) * 136 + 16 * ks + 8 * hi);
        a2 = MFMA32(A, B, a2); }
#pragma unroll
    for (int r = 0; r < 16; ++r) { const int jr = crow(r, hi); Hs[(32 * jb + jr) * 132 + 32 * vb + l32] = a1[r] * wsf[jr] + a2[r] * wsf[32 + jr]; }
    asm volatile("s_waitcnt lgkmcnt(0)" ::: "memory"); __builtin_amdgcn_s_barrier(); asm volatile("" ::: "memory");
    if (unit + G < 2048) MLO_LOADV(unit + G);
    { bf16_t* mix = (bf16_t*)(ws + WS_XB);
#pragma unroll
      for (int i = 0; i < 8; ++i) { const int jr = 8 * wid + i; const float x0 = Hs[jr * 132 + lane], x1 = Hs[jr * 132 + lane + 64];
          const float mean = wave_sum(x0 + x1) * (1.f / 128.f); const float d0 = x0 - mean, d1 = x1 - mean;
          const float rstd = 1.f / sqrtf(wave_sum(d0 * d0 + d1 * d1) * (1.f / 128.f) + LN_EPS);
          const float o0 = __uint_as_float(ogp[i] << 16), o1 = __uint_as_float(ogp[i] & 0xffff0000u);
          bf16_t* mp = mix + (row0 + jr) * D + 512 + h * 128;
          mp[lane] = f2bf(d0 * rstd * g0 * fsigmoid(o0)); mp[lane + 64] = f2bf(d1 * rstd * g1 * fsigmoid(o1)); } }
    asm volatile("s_waitcnt lgkmcnt(0)" ::: "memory"); __builtin_amdgcn_s_barrier(); asm volatile("" ::: "memory");
    }
#undef MLO_LOAD
#undef MLO_LOADV
}

namespace att {
constexpr int SLOT = 32768, NSLOT = 4, OFF_TAB = NSLOT * SLOT, OFF_WSF = OFF_TAB + 1024, OFF_BC = OFF_WSF + 2048;
constexpr float THR = 12.f;
#define ATT_WAIT_V(n) asm volatile("s_waitcnt vmcnt(" #n ")" ::: "memory")
#define ATT_BAR() do { asm volatile("s_waitcnt lgkmcnt(0)" ::: "memory"); __builtin_amdgcn_s_barrier(); asm volatile("" ::: "memory"); } while (0)

__device__ __forceinline__ float max3f(float a, float b, float c) { float r; asm("v_max3_f32 %0, %1, %2, %3" : "=v"(r) : "v"(a), "v"(b), "v"(c)); return r; }
__device__ __forceinline__ float sm_pre(f32x16& s, bool near, LAS const float* tp, float ref, bool first, bool guard, float& mhat, float& lsum, f32x16 (&o)[4], LAS float* wsf, int l32, int hi) {
    if (near) {
#pragma unroll
        for (int r = 0; r < 16; ++r) s[r] += tp[(r & 3) + 8 * (r >> 2)];
    }
    if (first) asm volatile("s_nop 0");
    if (guard) {
    float rm = max3f(s[0], s[1], s[2]); float rm2 = max3f(s[3], s[4], s[5]);
    rm = max3f(rm, s[6], s[7]); rm2 = max3f(rm2, s[8], s[9]); rm = max3f(rm, s[10], s[11]); rm2 = max3f(rm2, s[12], s[13]); rm = max3f(rm, s[14], s[15]);
    rm = max3f(rm, rm2, rm2);
    { auto rr = __builtin_amdgcn_permlane32_swap(__float_as_uint(rm), __float_as_uint(rm), false, false); rm = max3f(__uint_as_float(rr[0]), __uint_as_float(rr[1]), rm); }
    rm += ref - mhat;
    if (__any(rm > THR)) {
        const float dl = fmaxf(rm, 0.f);
        mhat += dl;
        {
            const float f = __builtin_amdgcn_exp2f(-dl);
            lsum *= f;
            if (hi == 0) wsf[l32] = f;
            asm volatile("s_waitcnt lgkmcnt(0)" ::: "memory");
#pragma unroll
            for (int r4 = 0; r4 < 4; ++r4) { const f32x4 fv = *(const LAS f32x4*)(wsf + 8 * r4 + 4 * hi);
#pragma unroll
                for (int d = 0; d < 4; ++d) { o[d][4 * r4] *= fv[0]; o[d][4 * r4 + 1] *= fv[1]; o[d][4 * r4 + 2] *= fv[2]; o[d][4 * r4 + 3] *= fv[3]; } }
            asm volatile("s_waitcnt lgkmcnt(0)" ::: "memory");
        }
    }
    }
    return ref - mhat;
}
__device__ __forceinline__ float fadd_s(float a, float b) { float r; asm("v_add_f32_e32 %0, %1, %2" : "=v"(r) : "v"(a), "v"(b)); return r; }
__device__ __forceinline__ void sm_exp(f32x16& s, float nsub, float& lsum, unsigned (&pk)[8]) {
    if (__any(nsub != 0.f)) {
#pragma unroll
        for (int r = 0; r < 16; ++r) s[r] += nsub;
    }
    float p0 = 0.f, p1 = 0.f, p2 = 0.f, p3 = 0.f;
#pragma unroll
    for (int r = 0; r < 16; r += 4) { const float a = __builtin_amdgcn_exp2f(s[r]), b = __builtin_amdgcn_exp2f(s[r + 1]), c = __builtin_amdgcn_exp2f(s[r + 2]), d = __builtin_amdgcn_exp2f(s[r + 3]);
        p0 = fadd_s(p0, a); p1 = fadd_s(p1, b); p2 = fadd_s(p2, c); p3 = fadd_s(p3, d);
        pk[r / 2] = cvtpk(a, b); pk[r / 2 + 1] = cvtpk(c, d); }
    lsum = fadd_s(lsum, fadd_s(fadd_s(p0, p1), fadd_s(p2, p3)));
}

__device__ __forceinline__ void attn_unit(const Args& a, LAS unsigned char* lds, float lam, int bh, int qb) {
    const int tid = threadIdx.x, lane = tid & 63, wid = __builtin_amdgcn_readfirstlane(tid >> 6), l32 = lane & 31, hi = lane >> 5;
    const int mp = wid >> 2, rg = wid & 3;
    const int b = bh >> 2, h = bh & 3;
    unsigned char* ws = a.ws;
    const bf16_t* proj = (const bf16_t*)(ws + WS_BIG);
    const bf16_t* VtG = (const bf16_t*)(ws + WS_VT);
    LAS float* tab = (LAS float*)(lds + OFF_TAB);
    LAS float* wsf = (LAS float*)(lds + OFF_WSF) + wid * 64;
    const size_t rowb = (size_t)b * SEQ;
    ATT_WAIT_V(0);
    if (tid < 256) { const int rel = tid - 191; const int n = rel < 0 ? -rel : rel; int bucket;
        if (n < 8) bucket = n; else { int lg = 31 - __clz(n * n); bucket = 2 + lg; if (bucket > 15) bucket = 15; }
        if (rel > 0) bucket += 16;
        tab[tid] = (a.in[23][bucket * 4 + h] - a.in[23][15 * 4 + h]) * LOG2E; }
    const int kvr = tid >> 3, kc = (tid & 7) ^ ((kvr >> 1) & 7);
    const bf16_t* ksrc = proj + (rowb + kvr) * NIN + 512 + h * 128 + 8 * kc;
    const bf16_t* vsrc = VtG + ((size_t)bh * 128 + kvr) * VSTR + 8 * kc;
#define ATT_ISSUE(t, slot) do { LAS unsigned char* _d = lds + (slot) * SLOT + wid * 1024; const bf16_t* _k = ksrc + (size_t)(t) * 64 * NIN; const bf16_t* _v = vsrc + (t) * 64; \
        __builtin_amdgcn_global_load_lds((const unsigned*)_k, (LAS unsigned*)_d, 16, 0, 0); \
        __builtin_amdgcn_global_load_lds((const unsigned*)(_k + 64), (LAS unsigned*)(_d + 8192), 16, 0, 0); \
        __builtin_amdgcn_global_load_lds((const unsigned*)_v, (LAS unsigned*)(_d + 16384), 16, 0, 0); \
        __builtin_amdgcn_global_load_lds((const unsigned*)(_v + (size_t)64 * VSTR), (LAS unsigned*)(_d + 24576), 16, 0, 0); } while (0)
    const int qrow = 128 * qb + 32 * rg + l32;
    bf16x8 qf[4];
    { const bf16_t* qp = proj + (rowb + qrow) * NIN + h * 128 + 64 * mp + 8 * hi;
#pragma unroll
      for (int d0 = 0; d0 < 4; ++d0) qf[d0] = *(const bf16x8*)(qp + 16 * d0); }
    const int NT = 2 * qb + 2, cq = 2 * qb + (rg >> 1);
    ATT_ISSUE(0, 0); ATT_ISSUE(1, 1); if (NT > 2) ATT_ISSUE(2, 2);
    f32x16 o[4];
#pragma unroll
    for (int d = 0; d < 4; ++d) o[d] = (f32x16){};
    float mhat = 0.f, lsum = 0.f;
#define ATT_KLD(tt, blk, KN) do { \
        int _sw = ((l32 >> 1) & 7) << 4; asm volatile("" : "+v"(_sw)); const int _xo = _sw ^ (hi << 4); \
        LAS const unsigned char* _kb = lds + ((tt) & 3) * SLOT + mp * 8192 + (blk) * 4096 + l32 * 128; \
        _Pragma("unroll") for (int d0 = 0; d0 < 4; ++d0) KN[d0] = *(const LAS bf16x8*)(_kb + (_xo ^ (d0 << 5))); } while (0)
#define ATT_SMM(KN, S) do { S = MFMA32(KN[0], qf[0], ((f32x16){})); _Pragma("unroll") for (int d0 = 1; d0 < 4; ++d0) S = MFMA32(KN[d0], qf[d0], S); } while (0)
#define ATT_S1(tt, blk, S) do { bf16x8 _kk[4]; ATT_KLD(tt, blk, _kk); ATT_SMM(_kk, S); } while (0)
#define ATT_VLD(DST, c) do { _Pragma("unroll") for (int d = 0; d < 4; ++d) DST[d] = *(const LAS bf16x8*)(_vb + d * 4096 + (_xv ^ ((c) << 4))); } while (0)
#define ATT_PV1(PK, jj, VF) do { const bf16x8 _P = __builtin_bit_cast(bf16x8, (u32x4){PK[4 * (jj)], PK[4 * (jj) + 1], PK[4 * (jj) + 2], PK[4 * (jj) + 3]}); \
        _Pragma("unroll") for (int d = 0; d < 4; ++d) o[d] = MFMA32(_P, VF[d], o[d]); } while (0)
#define ATT_FENCE() __builtin_amdgcn_sched_barrier(0)
#ifndef ATT_NOSCHED
#define SCHED_A() do { _Pragma("unroll") for (int _i = 0; _i < 4; ++_i) { __builtin_amdgcn_sched_group_barrier(0x008, 1, 0); __builtin_amdgcn_sched_group_barrier(0x002, 12, 0); } } while (0)
#else
#define SCHED_A() do {} while (0)
#endif
    f32x16 sX, sY;
    if (NT > 2) ATT_WAIT_V(8); else ATT_WAIT_V(4);
    ATT_BAR();
    ATT_S1(0, 0, sX);
    for (int t = 0; t < NT; ++t) {
        if (t + 3 <= NT) ATT_WAIT_V(4); else ATT_WAIT_V(0);
        ATT_BAR();
        if (t + 3 < NT) ATT_ISSUE(t + 3, (t + 3) & 3);
        if (t <= cq) {
            const bool near = (t >= cq - 2);
            int _swv = ((l32 >> 1) & 7) << 4; asm volatile("" : "+v"(_swv)); const int _xv = _swv ^ (hi << 4);
            LAS const unsigned char* _vb = lds + (t & 3) * SLOT + 16384 + l32 * 128;
            int relb = 64 * t - qrow + 191 + 4 * hi; asm volatile("" : "+v"(relb));
            LAS const float* tp = tab + relb;
            bf16x8 va[4], vc[4]; unsigned pk[8];
            const float ref = 0.f;
            bf16x8 kn[4];
            ATT_VLD(va, 0); ATT_VLD(vc, 2); ATT_KLD(t, 1, kn);
            const float nsX = sm_pre(sX, near, tp, ref, t == 0, (t & 3) == 0, mhat, lsum, o, wsf, l32, hi);
            ATT_FENCE();
            ATT_SMM(kn, sY);
            sm_exp(sX, nsX, lsum, pk);
            SCHED_A();
            ATT_FENCE();
            ATT_PV1(pk, 0, va); ATT_PV1(pk, 1, vc);
            ATT_FENCE();
            ATT_VLD(va, 4); ATT_VLD(vc, 6); ATT_KLD(t + 1, 0, kn);
            const float nsY = sm_pre(sY, near, tp + 32, ref, false, false, mhat, lsum, o, wsf, l32, hi);
            ATT_FENCE();
            ATT_SMM(kn, sX);
            sm_exp(sY, nsY, lsum, pk);
            SCHED_A();
            ATT_FENCE();
            ATT_PV1(pk, 0, va); ATT_PV1(pk, 1, vc);
            ATT_FENCE();
        }
    }
    int opq = 0; asm volatile("" : "+v"(opq));
    lsum += __shfl_xor(lsum, 32);
    if (hi == 0) wsf[l32] = (mp ? lam : 1.f) / lsum;
    asm volatile("s_waitcnt lgkmcnt(0)" ::: "memory");
#pragma unroll
    for (int r = 0; r < 16; ++r) { const float f = wsf[crow(r, hi)];
#pragma unroll
        for (int d = 0; d < 4; ++d) o[d][r] *= f; }
    ATT_BAR();
    LAS float* xch = (LAS float*)lds + rg * 4096 + lane + opq;
    if (mp == 1) {
#pragma unroll
        for (int d = 0; d < 4; ++d)
#pragma unroll
            for (int r = 0; r < 16; ++r) xch[(d * 16 + r) * 64] = o[d][r];
    }
    ATT_BAR();
    if (mp == 0) {
        float ss[16];
#pragma unroll
        for (int r = 0; r < 16; ++r) { float acc = 0.f;
#pragma unroll
            for (int d = 0; d < 4; ++d) { const float v = o[d][r] - xch[(d * 16 + r) * 64]; o[d][r] = v; acc += v * v; }
            ss[r] = acc; }
#pragma unroll
        for (int r = 0; r < 16; ++r) {
            ss[r] = half32_sum(ss[r]);
            ss[r] = (1.f - LAMBDA_INIT) / sqrtf(ss[r] * (1.f / 128.f) + LN_EPS); }
        bf16_t* mix = (bf16_t*)(ws + WS_XB) + (rowb + 128 * qb + 32 * rg) * D + h * 128 + opq;
        float gd[4];
#pragma unroll
        for (int d = 0; d < 4; ++d) gd[d] = a.in[14][32 * d + l32 + opq];
#pragma unroll
        for (int r = 0; r < 16; ++r)
#pragma unroll
            for (int d = 0; d < 4; ++d) mix[(size_t)crow(r, hi) * D + 32 * d + l32] = f2bf(o[d][r] * ss[r] * gd[d]);
    }
    ATT_BAR();
}
}

#define XB_TMO      128
#define XB_XCNT(j)  (256  + 64 * (j))
#define XB_XSUB(j)  (1280 + 64 * (j))
#define XB_XGEN(j)  (2304 + 64 * (j))
#define XB_TOP      3328
#define XB_TOPGEN   3392
#define XCD_BAR_WORDS 3456
#define XB_SPIN_CAP (1u << 20)
__device__ __forceinline__ unsigned xb_ld(unsigned* p)              { return __hip_atomic_load(p, __ATOMIC_RELAXED, __HIP_MEMORY_SCOPE_AGENT); }
__device__ __forceinline__ unsigned xb_add(unsigned* p, unsigned v) { return __hip_atomic_fetch_add(p, v, __ATOMIC_RELAXED, __HIP_MEMORY_SCOPE_AGENT); }
__device__ __forceinline__ unsigned xb_xcc_id() { return (unsigned)__builtin_amdgcn_s_getreg((3 << 11) | 20) & 0xFu; }
#define XB_SPIN(cond, bar) do { unsigned _sp = 0; while (cond) { __builtin_amdgcn_s_sleep(1); \
    if ((++_sp & 255u) == 0u) { if (xb_ld(&(bar)[XB_TMO])) break; if (_sp > XB_SPIN_CAP) { atomicAdd(&(bar)[XB_TMO], 1u); break; } } } } while (0)
struct XcdBarrier { unsigned* bar; unsigned x; volatile LAS unsigned* st; };
__device__ __forceinline__ XcdBarrier xcd_barrier_post(unsigned* bar, volatile LAS unsigned* st) {
    XcdBarrier b; b.bar = bar; b.x = xb_xcc_id(); b.st = st;
    if (threadIdx.x == 0) (void)xb_add(&bar[XB_XCNT(b.x)], 1u);
    return b;
}
__device__ __forceinline__ void xcd_barrier_complete(unsigned* bar, unsigned x, unsigned& nloc, unsigned& nx) {
    const unsigned G = gridDim.x * gridDim.y * gridDim.z;
    unsigned sum, cnt, mine, sp = 0u;
    for (;;) {
        sum = 0u; cnt = 0u; mine = 0u;
#pragma unroll
        for (unsigned j = 0; j < 16; ++j) { const unsigned c = xb_ld(&bar[XB_XCNT(j)]); sum += c; cnt += (c > 0u) ? 1u : 0u; mine = (j == x) ? c : mine; }
        if (sum == G) break;
        __builtin_amdgcn_s_sleep(1);
        if ((++sp & 255u) == 0u) { if (xb_ld(&bar[XB_TMO])) break; if (sp > XB_SPIN_CAP) { atomicAdd(&bar[XB_TMO], 1u); break; } }
    }
    nloc = mine > 0u ? mine : 1u; nx = cnt > 0u ? cnt : 1u;
}
__device__ __forceinline__ void xcd_barrier(const XcdBarrier& b) {
    asm volatile("s_waitcnt vmcnt(0)" ::: "memory");
    __syncthreads();
    if (threadIdx.x == 0) {
        unsigned* bar = b.bar;
        __builtin_amdgcn_s_waitcnt(0);
        unsigned nloc = b.st[0], nx = b.st[1];
        if (nloc == 0u) { xcd_barrier_complete(bar, b.x, nloc, nx); b.st[0] = nloc; b.st[1] = nx; }
        const unsigned old = xb_add(&bar[XB_XSUB(b.x)], 1u);
        const unsigned gen = old / nloc;
        if (old + 1u == (gen + 1u) * nloc) {
            __builtin_amdgcn_fence(__ATOMIC_RELEASE, "agent");
            asm volatile("s_waitcnt vmcnt(0)" ::: "memory");
            const unsigned og = xb_add(&bar[XB_TOP], 1u);
            const unsigned tg = og / nx;
            if (og + 1u == (tg + 1u) * nx) xb_add(&bar[XB_TOPGEN], 1u);
            else XB_SPIN(xb_ld(&bar[XB_TOPGEN]) == tg, bar);
            __builtin_amdgcn_fence(__ATOMIC_ACQUIRE, "agent");
            xb_add(&bar[XB_XGEN(b.x)], 1u);
            asm volatile("s_waitcnt vmcnt(0)" ::: "memory");
        } else {
            XB_SPIN(xb_ld(&bar[XB_XGEN(b.x)]) == gen, bar);
            __builtin_amdgcn_fence(__ATOMIC_ACQUIRE, "agent");
            asm volatile("s_waitcnt vmcnt(0)" ::: "memory");
        }
    }
    __syncthreads();
}

__global__ void __launch_bounds__(512) fwd_kernel(Args a) {
    extern __shared__ __attribute__((aligned(16))) unsigned char lds_raw[];
    LAS unsigned char* lds = (LAS unsigned char*)lds_raw;
    unsigned char* ws = a.ws;
    const int G = gridDim.x, bx = blockIdx.x;
    float* hbuf = a.out;
    const int lo = a.ph_lo, hi = a.ph_hi;
#ifndef PHMASK
#define PHMASK 0x1fff
#endif
#define IN(k) (((PHMASK >> (k)) & 1) && lo <= (k) && (k) < hi)
    volatile LAS unsigned* xst = (volatile LAS unsigned*)(lds + LDS_BYTES - 16);
    XcdBarrier xbar; xbar.bar = (unsigned*)(ws + 65536); xbar.x = 0; xbar.st = xst;
    bool xposted = false;
#define SEAM(k) do { if ((k) + 1 < hi) { if ((k) == 0) { __syncthreads(); cg::this_grid().sync(); } \
        else { if (!xposted) { if (threadIdx.x == 0) { xst[0] = 0u; xst[1] = 0u; } __syncthreads(); xbar = xcd_barrier_post((unsigned*)(ws + 65536), xst); xposted = true; } xcd_barrier(xbar); } } } while (0)
    if (IN(0)) { if (bx == 0) { if (threadIdx.x < 8) ((unsigned*)ws)[64 * threadIdx.x] = 0u; for (int i = threadIdx.x; i < XCD_BAR_WORDS; i += 512) ((unsigned*)(ws + 65536))[i] = 0u; }
                 p0_prologue(a, lds); SEAM(0); }
    if (IN(1)) { pg8::Gemm g{(const bf16_t*)(ws + WS_XB), (const bf16_t*)(ws + WS_WUP1), M, NUP, D}; pg8::StaticOrder S; S.init(M, NUP, G, bx);
                 pg8::EpiSwiGLU E{(bf16_t*)(ws + WS_BIG), FF}; pg8::gemm_phase(lds, g, S, E); SEAM(1); }
    if (IN(2)) { pg8::Gemm g{(const bf16_t*)(ws + WS_BIG), (const bf16_t*)(ws + WS_WD1), M, D, FF}; pg8::StaticOrder S; S.init(M, D, G, bx);
                 pg8::EpiResid E{a.in[0], hbuf, ALPHA, 0.5f}; pg8::gemm_phase(lds, g, S, E); SEAM(2); }
    if (IN(3)) { ln_phase<true, true>(a, lds, hbuf, a.in[1], a.in[2]); SEAM(3); }
    if (IN(4)) { pg8::Gemm g{(const bf16_t*)(ws + WS_XB), (const bf16_t*)(ws + WS_WIN), M, NIN, D}; pg8::StaticOrder S; S.init(M, NIN, G, bx);
                 pg8::EpiBf16 E{(bf16_t*)(ws + WS_BIG), NIN}; pg8::gemm_phase(lds, g, S, E); SEAM(4); }
    if (IN(5)) { for (int u = bx; u < 2048 + 512; u += G) { if (u < 2048) ml_pre_unit(a, lds, u); else vt_unit(a, lds, u - 2048); } SEAM(5); }
    if (IN(6)) {
        ml_scan(a);
        float lam;
        { float s1 = 0.f, s2 = 0.f;
          for (int i = 0; i < 64; ++i) { s1 += a.in[10][i] * a.in[11][i]; s2 += a.in[12][i] * a.in[13][i]; }
          lam = expf(s1) - expf(s2) + LAMBDA_INIT; }
        unsigned* ctr = (unsigned*)ws;
        LAS int* bc = (LAS int*)(lds + att::OFF_BC);
        const int my = (int)(__builtin_amdgcn_s_getreg((3 << 11) | 20) & 7u);
        for (int k = 0; k < 8; ++k) { const int bh = (my + k) & 7;
            for (;;) { if (threadIdx.x == 0) *bc = (int)atomicAdd(ctr + 64 * bh, 1u);
                SYNC(); const int idx = *bc; SYNC();
                if (idx >= 128) break;
                att::attn_unit(a, lds, lam, bh, 127 - idx); } }
        SEAM(6);
    }
    if (IN(7)) {
        ml_out_phase(a, lds);
        SEAM(7);
    }
    if (IN(8)) { pg8::Gemm g{(const bf16_t*)(ws + WS_XB), (const bf16_t*)(ws + WS_WOUT), M, D, D}; pg8::StaticOrder S; S.init(M, D, G, bx);
                 pg8::EpiResid E{hbuf, hbuf, ALPHA, 1.0f}; pg8::gemm_phase(lds, g, S, E); SEAM(8); }
    if (IN(9)) { ln_phase<true, false>(a, lds, hbuf, a.in[17], a.in[18]); SEAM(9); }
    if (IN(10)) { pg8::Gemm g{(const bf16_t*)(ws + WS_XB), (const bf16_t*)(ws + WS_WUP2), M, NUP, D}; pg8::StaticOrder S; S.init(M, NUP, G, bx);
                  pg8::EpiSwiGLU E{(bf16_t*)(ws + WS_BIG), FF}; pg8::gemm_phase(lds, g, S, E); SEAM(10); }
    if (IN(11)) { pg8::Gemm g{(const bf16_t*)(ws + WS_BIG), (const bf16_t*)(ws + WS_WD2), M, D, FF}; pg8::StaticOrder S; S.init(M, D, G, bx);
                  pg8::EpiResid E{hbuf, hbuf, ALPHA, 0.5f}; pg8::gemm_phase(lds, g, S, E); SEAM(11); }
    if (IN(12)) { ln_phase<false, false>(a, lds, hbuf, a.in[21], a.in[22]); }
}

constexpr int N_PHASES = 13;

extern "C" void kernel_launch(void* const* d_in, const int* in_sizes, int n_in, void* d_out, int out_size, void* d_ws, size_t ws_size, hipStream_t stream) {
    static int grid = 0;
    if (grid == 0) {
        if (n_in != 24 || out_size != M * D || ws_size < WS_END) { fprintf(stderr, "kernel_launch: unexpected shapes n_in %d out %d ws %zu\n", n_in, out_size, ws_size); grid = -1; return; }
        int dev = 0, cus = 0, per_cu = 0;
        hipGetDevice(&dev);
        hipDeviceGetAttribute(&cus, hipDeviceAttributeMultiprocessorCount, dev);
        if (hipFuncSetAttribute((const void*)fwd_kernel, hipFuncAttributeMaxDynamicSharedMemorySize, LDS_BYTES) != hipSuccess) { fprintf(stderr, "hipFuncSetAttribute failed\n"); }
        hipOccupancyMaxActiveBlocksPerMultiprocessor(&per_cu, (const void*)fwd_kernel, 512, LDS_BYTES);
        (void)hipGetLastError();
        if (per_cu < 1) per_cu = 1;
        grid = cus * per_cu;
        if (grid > 256) grid = 256;
    }
    if (grid < 0) return;
    Args a{};
    for (int i = 0; i < 24; ++i) a.in[i] = (const float*)d_in[i];
    a.out = (float*)d_out; a.ws = (unsigned char*)d_ws;
#if ONE_LAUNCH
    a.ph_lo = 0; a.ph_hi = N_PHASES;
    void* args[] = {&a};
    hipError_t e = hipLaunchCooperativeKernel((const void*)fwd_kernel, dim3(grid), dim3(512), args, LDS_BYTES, stream);
    if (e != hipSuccess) fprintf(stderr, "cooperative launch failed: %s (grid %d)\n", hipGetErrorString(e), grid);
#else
    for (int ph = 0; ph < N_PHASES; ++ph) { a.ph_lo = ph; a.ph_hi = ph + 1;
        hipLaunchKernelGGL(fwd_kernel, dim3(grid), dim3(512), LDS_BYTES, stream, a); }
#endif
}
```
